# Optimizing an MI355X kernel written in HIP

```python
import jax, jax.numpy as jnp
from jax import lax
import numpy as np

D_MODEL = 1024
BATCH = 8
SEQ = 4096
DEPTH = 2

GRID_W = 64
CTX_LEN = 256
N_EVEN = (DEPTH + 1) // 2
N_ODD = DEPTH // 2
EPS = 1e-6

SGU_GROUPS = 4
SGU_GROUP_DIM = 128
SGU_DIM = SGU_GROUPS * SGU_GROUP_DIM
SGU_CHUNK = 128
HGRN_HEADS = 4
HGRN_KDIM = 128
HGRN_VDIM = 128
HGRN_DIM = HGRN_HEADS * HGRN_KDIM
HGRN_CHUNK = 64
AB_IN = 2 * SGU_DIM + 5 * HGRN_DIM
AB_OUT = SGU_DIM + HGRN_DIM
ATTN_HEADS = 16
ATTN_KV_HEADS = 4
ATTN_GROUP = ATTN_HEADS // ATTN_KV_HEADS
HEAD_DIM = 64
ATTN_Q_DIM = ATTN_HEADS * HEAD_DIM
QKV_DIM = (ATTN_HEADS + 2 * ATTN_KV_HEADS) * HEAD_DIM
WINDOW = 128
ATTN_BLOCK = 128
ROPE_BASE = 10000.0
N_EXPERTS = 16
CAPACITY_FACTOR = 2
EXPERT_FF = 2048

kernel_name = "hybrid_sgu_hgrn2_swa_ec_moe_diffusion"


def _rmsnorm(x, g):
    xf = x.astype(jnp.float32)
    y = xf * lax.rsqrt(jnp.mean(xf * xf, axis=-1, keepdims=True) + EPS)
    return (y * g.astype(jnp.float32)).astype(x.dtype)


def _modulate(x, g, shift, scale):
    return _rmsnorm(x, g) * (1 + scale) + shift


def _chunk_sgu(zu, zv, w_s, b_s):
    B, N, _ = zu.shape
    nc = N // SGU_CHUNK
    u = jax.nn.gelu(zu, approximate=False)
    v = jax.nn.gelu(zv, approximate=False).reshape(B, nc, SGU_CHUNK, SGU_GROUPS, SGU_GROUP_DIM)
    vf = v.astype(jnp.float32)
    mu = jnp.mean(vf, axis=-1, keepdims=True)
    var = jnp.mean(jnp.square(vf - mu), axis=-1, keepdims=True)
    vn = ((vf - mu) * lax.rsqrt(var + EPS)).astype(zv.dtype)
    s = jnp.einsum('gts,bnsgc->bntgc', w_s, vn) + b_s.T[:, :, None]
    return u * s.reshape(B, N, SGU_DIM)


def _gla_scan(q, k, v, log_f, s0):
    B, H, N, K = q.shape
    nc = N // HGRN_CHUNK

    def to_chunks(a):
        return jnp.moveaxis(a.reshape(B, H, nc, HGRN_CHUNK, a.shape[-1]), 2, 0)

    tri = jnp.tril(jnp.ones((HGRN_CHUNK, HGRN_CHUNK), dtype=bool))[:, :, None]

    def step(S, inp):
        qc, kc, vc, gc = inp
        b = jnp.cumsum(gc, axis=2)
        o_inter = jnp.einsum('bhtk,bhkv->bhtv', qc * jnp.exp(b), S)
        rel = jnp.exp(jnp.where(tri, b[:, :, :, None, :] - b[:, :, None, :, :], -jnp.inf))
        a = jnp.einsum('bhtk,bhsk,bhtsk->bhts', qc, kc, rel)
        o_intra = jnp.einsum('bhts,bhsv->bhtv', a, vc)
        b_end = b[:, :, -1:, :]
        S = jnp.exp(b_end[:, :, 0, :, None]) * S + jnp.einsum('bhsk,bhsv->bhkv', kc * jnp.exp(b_end - b), vc)
        return S, o_inter + o_intra

    s_fin, o = lax.scan(step, s0, (to_chunks(q), to_chunks(k), to_chunks(v), to_chunks(log_f)))
    return jnp.moveaxis(o, 0, 2).reshape(B, H, N, v.shape[-1]), s_fin


def _hgrn2(zq, zf_fwd, zf_bwd, zi, lb, s0):
    B, N, _ = zq.shape

    def heads(a):
        return a.astype(jnp.float32).reshape(B, N, HGRN_HEADS, -1).transpose(0, 2, 1, 3)

    q = heads(jax.nn.silu(zq))
    v = heads(zi)
    outs, finals = [], []
    for d, zf in enumerate((zf_fwd, zf_bwd)):
        f = heads(lb[d] + (1.0 - lb[d]) * jax.nn.sigmoid(zf.astype(jnp.float32)))
        args = (q, 1.0 - f, v, jnp.log(f))
        if d == 1:
            args = tuple(jnp.flip(a, axis=2) for a in args)
        o, s_fin = _gla_scan(*args, s0[d])
        outs.append(jnp.flip(o, axis=2) if d == 1 else o)
        finals.append(s_fin)
    return outs[0] + outs[1], jnp.stack(finals)


def _even_mixer(h, w_in, w_out, sgu_w, sgu_b, lb, norm_g, s0):
    B, N, _ = h.shape
    z = h @ w_in
    cuts = [SGU_DIM, 2 * SGU_DIM] + [2 * SGU_DIM + i * HGRN_DIM for i in range(1, 5)]
    zu, zv, zq, zf_fwd, zf_bwd, zi, zg = jnp.split(z, cuts, axis=-1)
    y_a = _chunk_sgu(zu, zv, sgu_w, sgu_b)
    o, states = _hgrn2(zq, zf_fwd, zf_bwd, zi, lb, s0)
    o = o * lax.rsqrt(jnp.mean(o * o, axis=-1, keepdims=True) + EPS) * norm_g.astype(jnp.float32)[:, None, :]
    y_b = o.transpose(0, 2, 1, 3).reshape(B, N, HGRN_DIM).astype(h.dtype) * jax.nn.silu(zg)
    return jnp.concatenate([y_a, y_b], axis=-1) @ w_out, states


def _rope_2d(x, row, col):
    half = HEAD_DIM // 2
    quarter = half // 2
    inv = ROPE_BASE ** (-jnp.arange(quarter, dtype=jnp.float32) / quarter)

    def rot(xa, pos):
        ang = pos.astype(jnp.float32)[:, None] * inv[None, :]
        cos, sin = jnp.cos(ang), jnp.sin(ang)
        x1, x2 = xa[..., :quarter], xa[..., quarter:]
        return jnp.concatenate([x1 * cos - x2 * sin, x2 * cos + x1 * sin], axis=-1)

    xf = x.astype(jnp.float32)
    return jnp.concatenate([rot(xf[..., :half], row), rot(xf[..., half:], col)], axis=-1).astype(x.dtype)


def _sink_softmax(scores, sink):
    s_sink = jnp.broadcast_to(sink.astype(jnp.float32), scores.shape[:-1] + (1,))
    return jax.nn.softmax(jnp.concatenate([scores, s_sink], axis=-1), axis=-1)[..., :-1]


def _window_attention(h_lat, h_ctx, w_qkv, w_out, sink, need_ctx):
    B, N, _ = h_lat.shape
    Lc = h_ctx.shape[1]
    scale = HEAD_DIM ** -0.5
    sink_b = sink.reshape(ATTN_KV_HEADS, ATTN_GROUP, 1, 1)

    def split_q(zq, L):
        return zq.reshape(B, L, ATTN_KV_HEADS, ATTN_GROUP, HEAD_DIM).transpose(0, 2, 3, 1, 4)

    def split_kv(zkv, L):
        k, v = jnp.split(zkv, 2, axis=-1)
        k = k.reshape(B, L, ATTN_KV_HEADS, HEAD_DIM).transpose(0, 2, 1, 3)
        v = v.reshape(B, L, ATTN_KV_HEADS, HEAD_DIM).transpose(0, 2, 1, 3)
        return k, v

    kc, vc = split_kv(h_ctx @ w_qkv[:, ATTN_Q_DIM:], Lc)
    z = h_lat @ w_qkv
    q = split_q(z[..., :ATTN_Q_DIM], N)
    k, v = split_kv(z[..., ATTN_Q_DIM:], N)
    t = jnp.arange(N)
    row, col = t // GRID_W, t % GRID_W
    q = _rope_2d(q, row, col)
    k = _rope_2d(k, row, col)

    nb = N // ATTN_BLOCK
    pad = [(0, 0), (0, 0), (ATTN_BLOCK, ATTN_BLOCK), (0, 0)]
    kp, vp = jnp.pad(k, pad), jnp.pad(v, pad)
    r_idx = jnp.arange(ATTN_BLOCK)[:, None]
    s_idx = jnp.arange(3 * ATTN_BLOCK)[None, :]
    band = jnp.abs(s_idx - r_idx - ATTN_BLOCK) <= WINDOW

    def block(bi):
        start = bi * ATTN_BLOCK
        qb = lax.dynamic_slice_in_dim(q, start, ATTN_BLOCK, axis=3)
        kb = lax.dynamic_slice_in_dim(kp, start, 3 * ATTN_BLOCK, axis=2)
        vb = lax.dynamic_slice_in_dim(vp, start, 3 * ATTN_BLOCK, axis=2)
        j = start - ATTN_BLOCK + s_idx
        valid = band & (j >= 0) & (j < N)
        s_loc = jnp.einsum('bkgqd,bksd->bkgqs', qb, kb).astype(jnp.float32) * scale
        s_loc = jnp.where(valid, s_loc, -jnp.inf)
        s_ctx = jnp.einsum('bkgqd,bksd->bkgqs', qb, kc).astype(jnp.float32) * scale
        p = _sink_softmax(jnp.concatenate([s_loc, s_ctx], axis=-1), sink_b)
        p_loc = p[..., :3 * ATTN_BLOCK].astype(v.dtype)
        p_ctx = p[..., 3 * ATTN_BLOCK:].astype(v.dtype)
        return jnp.einsum('bkgqs,bksd->bkgqd', p_loc, vb) + jnp.einsum('bkgqs,bksd->bkgqd', p_ctx, vc)

    o = lax.map(block, jnp.arange(nb))
    y_lat = o.transpose(1, 0, 4, 2, 3, 5).reshape(B, N, ATTN_Q_DIM) @ w_out

    y_ctx = None
    if need_ctx:
        qc = split_q(h_ctx @ w_qkv[:, :ATTN_Q_DIM], Lc)
        sc = jnp.einsum('bkgqd,bksd->bkgqs', qc, kc).astype(jnp.float32) * scale
        pc = _sink_softmax(sc, sink_b).astype(vc.dtype)
        oc = jnp.einsum('bkgqs,bksd->bkgqd', pc, vc)
        y_ctx = oc.transpose(0, 3, 1, 2, 4).reshape(B, Lc, ATTN_Q_DIM) @ w_out
    return y_lat, y_ctx


def _expert_choice_ffn(h, w_r, w1, w3, w2):
    B, N, D = h.shape
    cap = CAPACITY_FACTOR * N // N_EXPERTS
    aff = jax.nn.softmax((h @ w_r).astype(jnp.float32), axis=-1)
    gate, idx = lax.top_k(jnp.swapaxes(aff, 1, 2), cap)
    xe = jax.vmap(lambda hb, ib: hb[ib])(h, idx)
    a = jnp.einsum('becd,edf->becf', xe, w1)
    u = jnp.einsum('becd,edf->becf', xe, w3)
    y = jnp.einsum('becf,efd->becd', jax.nn.silu(a) * u, w2) * gate[..., None].astype(h.dtype)
    return jax.vmap(lambda yb, ib: jnp.zeros((N, D), yb.dtype).at[ib.reshape(-1)].add(yb.reshape(-1, D)))(y, idx)


def setup_inputs(seed: int = 0) -> dict:
    key = jax.random.key(seed)
    ks = jax.random.split(key, 24)
    D = D_MODEL

    def nrm(k, shape, s):
        return jax.random.normal(k, shape, jnp.float32) * s

    return {
        "x": nrm(ks[0], (BATCH, SEQ, D), 1.0),
        "c": nrm(ks[1], (BATCH, D), 1.0),
        "ctx": nrm(ks[2], (BATCH, CTX_LEN, D), 1.0),
        "c_ctx": nrm(ks[3], (D,), 1.0),
        "mod_w": nrm(ks[4], (DEPTH, D, 6 * D), 0.5 * D ** -0.5),
        "mod_b": nrm(ks[5], (DEPTH, 6 * D), 0.02),
        "norm1_g": 1.0 + nrm(ks[6], (DEPTH, D), 0.02),
        "norm2_g": 1.0 + nrm(ks[7], (DEPTH, D), 0.02),
        "ab_w_in": nrm(ks[8], (N_EVEN, D, AB_IN), D ** -0.5),
        "ab_w_out": nrm(ks[9], (N_EVEN, AB_OUT, D), AB_OUT ** -0.5),
        "sgu_w": nrm(ks[10], (N_EVEN, SGU_GROUPS, SGU_CHUNK, SGU_CHUNK), SGU_CHUNK ** -0.5),
        "sgu_b": 1.0 + nrm(ks[11], (N_EVEN, SGU_GROUPS, SGU_CHUNK), 0.02),
        "hgrn_lb_logits": nrm(ks[12], (N_EVEN + 1, 2, HGRN_DIM), 1.0),
        "hgrn_norm_g": 1.0 + nrm(ks[13], (N_EVEN, HGRN_HEADS, HGRN_VDIM), 0.02),
        "attn_w_qkv": nrm(ks[14], (N_ODD, D, QKV_DIM), D ** -0.5),
        "attn_w_out": nrm(ks[15], (N_ODD, ATTN_Q_DIM, D), ATTN_Q_DIM ** -0.5),
        "attn_sink": nrm(ks[16], (N_ODD, ATTN_HEADS), 1.0),
        "router_w": nrm(ks[17], (DEPTH, D, N_EXPERTS), D ** -0.5),
        "expert_w1": nrm(ks[18], (DEPTH, N_EXPERTS, D, EXPERT_FF), D ** -0.5),
        "expert_w3": nrm(ks[19], (DEPTH, N_EXPERTS, D, EXPERT_FF), D ** -0.5),
        "expert_w2": nrm(ks[20], (DEPTH, N_EXPERTS, EXPERT_FF, D), EXPERT_FF ** -0.5),
        "final_g": 1.0 + nrm(ks[21], (D,), 0.02),
    }


def reference(x, c, ctx, c_ctx, mod_w, mod_b, norm1_g, norm2_g, ab_w_in, ab_w_out, sgu_w, sgu_b,
              hgrn_lb_logits, hgrn_norm_g, attn_w_qkv, attn_w_out, attn_sink, router_w,
              expert_w1, expert_w3, expert_w2, final_g):
    B = x.shape[0]
    lb_all = jnp.cumsum(jax.nn.softmax(hgrn_lb_logits.astype(jnp.float32), axis=0), axis=0)
    x_lat, x_ctx = x, ctx
    for l in range(DEPTH):
        last = l == DEPTH - 1
        mod_lat = (jax.nn.silu(c) @ mod_w[l] + mod_b[l])[:, None, :]
        mod_ctx = (jax.nn.silu(c_ctx) @ mod_w[l] + mod_b[l])[None, None, :]
        sh1, sc1, g1, sh2, sc2, g2 = jnp.split(mod_lat, 6, axis=-1)
        csh1, csc1, cg1, csh2, csc2, cg2 = jnp.split(mod_ctx, 6, axis=-1)
        h_lat = _modulate(x_lat, norm1_g[l], sh1, sc1)
        h_ctx = _modulate(x_ctx, norm1_g[l], csh1, csc1)
        if l % 2 == 0:
            e = l // 2
            params = (ab_w_in[e], ab_w_out[e], sgu_w[e], sgu_b[e], lb_all[e], hgrn_norm_g[e])
            s0 = jnp.zeros((2, B, HGRN_HEADS, HGRN_KDIM, HGRN_VDIM), jnp.float32)
            y_ctx, s_ctx = _even_mixer(h_ctx, *params, s0)
            y_lat, _ = _even_mixer(h_lat, *params, s_ctx)
        else:
            o = l // 2
            y_lat, y_ctx = _window_attention(h_lat, h_ctx, attn_w_qkv[o], attn_w_out[o], attn_sink[o], not last)
        moe = (router_w[l], expert_w1[l], expert_w3[l], expert_w2[l])
        x_lat = x_lat + g1 * y_lat
        x_lat = x_lat + g2 * _expert_choice_ffn(_modulate(x_lat, norm2_g[l], sh2, sc2), *moe)
        if not last:
            x_ctx = x_ctx + cg1 * y_ctx
            x_ctx = x_ctx + cg2 * _expert_choice_ffn(_modulate(x_ctx, norm2_g[l], csh2, csc2), *moe)
    return _rmsnorm(x_lat, final_g)
```

```cpp
#include <hip/hip_runtime.h>
#include <cstdio>
#include <cstdint>
#include <cmath>

#define LAS __attribute__((address_space(3)))
#define GAS __attribute__((address_space(1)))
typedef unsigned short bf16_t;
typedef short bf16x8 __attribute__((ext_vector_type(8)));
typedef short s16x4 __attribute__((ext_vector_type(4)));
typedef float f32x4 __attribute__((ext_vector_type(4)));
typedef float f32x2 __attribute__((ext_vector_type(2)));
typedef float f32x16 __attribute__((ext_vector_type(16)));
typedef unsigned u32x4 __attribute__((ext_vector_type(4)));
typedef unsigned u32x2 __attribute__((ext_vector_type(2)));
typedef GAS unsigned gu32;

#ifndef DBG_SKIP
#define DBG_SKIP 0
#endif

constexpr int NB = 8, SEQ = 4096, CTXL = 256, DM = 1024, TPS = SEQ + CTXL, MROWS = NB * TPS;
constexpr int ABIN = 3584, NE = 16, FF = 2048, QKVD = 1536;
constexpr int CAP_LAT = 512, CAP_CTX = 32;
constexpr float EPS = 1e-6f;
constexpr int NWAVES = 8, NTHR = 512;

constexpr size_t MiB = 1u << 20;
constexpr size_t WS_CTL = 0, CTL_ZERO_BYTES = 1 * MiB;
constexpr size_t WS_MOD = 1 * MiB;
constexpr size_t WS_ROPE = 1 * MiB + 512 * 1024;
constexpr size_t WS_WIN = 2 * MiB;
constexpr size_t WS_WOUT = 9 * MiB;
constexpr size_t WS_WQKV = 11 * MiB;
constexpr size_t WS_WAO = 14 * MiB;
constexpr size_t WS_AFF = 16 * MiB;
constexpr size_t WS_SLOT = 19 * MiB;
constexpr size_t WS_RLIST = 22 * MiB;
constexpr size_t WS_W13 = 24 * MiB;
constexpr size_t WS_W2 = 152 * MiB;
constexpr size_t WS_X = 216 * MiB;
constexpr size_t WS_XN = 352 * MiB;
constexpr size_t WS_Y = 420 * MiB;
constexpr size_t WS_R1 = 488 * MiB;
constexpr size_t WS_R2 = 760 * MiB;
constexpr size_t WS_END = 896 * MiB;
constexpr int CW_BAR = 4096;

constexpr int RING_BYTES = 131072;
constexpr int LDSCTL_OFF = RING_BYTES + 17408, MISC_OFF = LDSCTL_OFF + 320;
constexpr int LDS_BYTES = 155648;
static_assert(MISC_OFF + 128 <= LDS_BYTES, "LDS map");

__device__ __forceinline__ unsigned f2bf(float f) { unsigned u = __builtin_bit_cast(unsigned, f); return (u + 0x7fffu + ((u >> 16) & 1u)) >> 16; }
__device__ __forceinline__ unsigned pk2(float lo, float hi) { return f2bf(lo) | (f2bf(hi) << 16); }
__device__ __forceinline__ float bf2f(unsigned b) { return __builtin_bit_cast(float, b << 16); }
__device__ __forceinline__ float bflo(unsigned w) { return __builtin_bit_cast(float, w << 16); }
__device__ __forceinline__ float bfhi(unsigned w) { return __builtin_bit_cast(float, w & 0xffff0000u); }
__device__ __forceinline__ float wave_sum(float v) {
#pragma unroll
    for (int o = 1; o < 64; o <<= 1) v += __shfl_xor(v, o);
    return v;
}
__device__ __forceinline__ float silu_f(float x) { return x / (1.f + __expf(-x)); }
__device__ __forceinline__ float sigmoid_f(float x) { return 1.f / (1.f + __expf(-x)); }
__device__ __forceinline__ float gelu_f(float x) { return 0.5f * x * (1.f + erff(x * 0.70710678118654752f)); }
#define LDS_WAIT() asm volatile("s_waitcnt lgkmcnt(0)" ::: "memory")

namespace pg8 {
constexpr int BM = 256, BK = 64, HALF = 128, HTB = HALF * BK * 2, STAGE_BYTES = 8 * HTB, NXCD = 8, WGM = 8;
__host__ __device__ __forceinline__ int lds_byte(int r, int c) { const int st = (r >> 4) * 2 + (c >> 5), rr = r & 15, cc = c & 31, ob = rr * 64 + cc * 2; return st * 1024 + (ob ^ (((ob >> 9) & 1) << 5)); }
__host__ __device__ __forceinline__ void stage_rc(int b, int& R, int& C) { const int st = b / 1024, sb = b % 1024, swz = sb ^ (((sb >> 9) & 1) << 5); R = (st >> 1) * 16 + swz / 64; C = (st & 1) * 32 + (swz % 64) / 2; }
__host__ __device__ __forceinline__ int perm32(int rho) { const int n = rho >> 4, i = rho & 15; return 8 * (i >> 2) + 4 * n + (i & 3); }

struct Unit { int pm, pn, pc; };
struct Gemm { const bf16_t* A; const bf16_t* Bt; int K; const int* rowlist; };

struct Order {
    int nM, nN, ngroups, G, c, latonly, amul, bmul;
    __device__ __forceinline__ bool next(int i, Unit& u) const {
        const int per = nM * nN, nwg = per * ngroups;
        const long L = (long)i * G + c; if (L >= nwg) return false;
        int wgid = (int)L; { const int q = nwg / NXCD, r = nwg % NXCD, xcd = wgid % NXCD, off = wgid / NXCD; wgid = (xcd < r ? xcd * (q + 1) : r * (q + 1) + (xcd - r) * q) + off; }
        const int grp = wgid / per, w = wgid - grp * per;
        const int nig = WGM * nN, gid = w / nig, fm = gid * WGM, gsz = (nM - fm) < WGM ? (nM - fm) : WGM;
        int pm = fm + ((w % nig) % gsz); const int pn = (w % nig) / gsz;
        if (latonly) pm = (pm >> 4) * 17 + 1 + (pm & 15);
        u.pm = grp * amul + pm; u.pn = grp * bmul + pn; u.pc = pn; return true;
    }
};

__device__ __forceinline__ unsigned cvt_pk_bf16(float lo, float hi) { unsigned r; asm volatile("v_cvt_pk_bf16_f32 %0, %1, %2" : "=v"(r) : "v"(lo), "v"(hi)); return r; }

struct EpiStore {
    static constexpr bool PERM = true;
    bf16_t* O; int ldc;
    __device__ __forceinline__ void operator()(const f32x4 (&acc)[2][2][4][2], const Unit& u, int wr, int wc, int fr, int fq) const {
        const int row0 = u.pm * BM + wr * 64 + fr, col0 = u.pc * BM + wc * 32 + 8 * fq;
#pragma unroll
        for (int ai = 0; ai < 2; ++ai)
#pragma unroll
            for (int m = 0; m < 4; ++m) { bf16_t* rowp = O + (size_t)(row0 + ai * HALF + m * 16) * ldc + col0;
#pragma unroll
                for (int bj = 0; bj < 2; ++bj) { const f32x4 v0 = acc[ai][bj][m][0], v1 = acc[ai][bj][m][1];
                    u32x4 w; w.x = cvt_pk_bf16(v0[0], v0[1]); w.y = cvt_pk_bf16(v0[2], v0[3]); w.z = cvt_pk_bf16(v1[0], v1[1]); w.w = cvt_pk_bf16(v1[2], v1[3]);
                    *(u32x4*)(rowp + bj * HALF) = w; } }
    }
};
struct EpiSwiglu {
    static constexpr bool PERM = true;
    bf16_t* O;
    __device__ __forceinline__ void operator()(const f32x4 (&acc)[2][2][4][2], const Unit& u, int wr, int wc, int fr, int fq) const {
        const int row0 = u.pm * BM + wr * 64 + fr, col0 = u.pc * HALF + wc * 32 + 8 * fq;
#pragma unroll
        for (int ai = 0; ai < 2; ++ai)
#pragma unroll
            for (int m = 0; m < 4; ++m) { bf16_t* rowp = O + (size_t)(row0 + ai * HALF + m * 16) * FF + col0;
                float o[8];
#pragma unroll
                for (int n = 0; n < 2; ++n)
#pragma unroll
                    for (int i = 0; i < 4; ++i) { const float a = acc[ai][0][m][n][i], g = acc[ai][1][m][n][i]; o[n * 4 + i] = (a / (1.f + __expf(-a))) * g; }
                u32x4 w; w.x = cvt_pk_bf16(o[0], o[1]); w.y = cvt_pk_bf16(o[2], o[3]); w.z = cvt_pk_bf16(o[4], o[5]); w.w = cvt_pk_bf16(o[6], o[7]);
                *(u32x4*)rowp = w; }
    }
};
struct EpiResid {
    static constexpr bool PERM = false;
    const float* xl; const float* xc; float* X; const float* modl; int fromin; float gmul;
    __device__ __forceinline__ void operator()(const f32x4 (&acc)[2][2][4][2], const Unit& u, int wr, int wc, int fr, int fq) const {
        const int b = u.pm / 17, j = u.pm - b * 17, s = (j == 0) ? 8 : b;
        const float* gate = modl + s * 6144 + 2048;
        const float* src = fromin ? ((j == 0) ? xc + (size_t)(b * CTXL) * DM : xl + (size_t)(b * SEQ + (j - 1) * 256) * DM) : X + (size_t)u.pm * BM * DM;
        float* dst = X + (size_t)u.pm * BM * DM;
        const int col0 = u.pc * BM + wc * 32 + 4 * fq;
        f32x4 gv[2][2];
#pragma unroll
        for (int bj = 0; bj < 2; ++bj)
#pragma unroll
            for (int n = 0; n < 2; ++n) gv[bj][n] = *(const f32x4*)(gate + col0 + bj * HALF + n * 16) * gmul;
#pragma unroll
        for (int ai = 0; ai < 2; ++ai)
#pragma unroll
            for (int m = 0; m < 4; ++m) { const size_t off = (size_t)(ai * HALF + wr * 64 + m * 16 + fr) * DM + col0;
#pragma unroll
                for (int bj = 0; bj < 2; ++bj)
#pragma unroll
                    for (int n = 0; n < 2; ++n) { const f32x4 xs = *(const f32x4*)(src + off + bj * HALF + n * 16); *(f32x4*)(dst + off + bj * HALF + n * 16) = xs + gv[bj][n] * acc[ai][bj][m][n]; } }
    }
};
struct EpiQkv {
    static constexpr bool PERM = false;
    bf16_t* O; const float* ropec; const float* ropes;
    __device__ __forceinline__ void operator()(const f32x4 (&acc)[2][2][4][2], const Unit& u, int wr, int wc, int fr, int fq) const {
        const int b = u.pm / 17, j = u.pm - b * 17;
        const bool dorope = (j != 0) && (u.pc <= 4);
        const int col0 = u.pc * BM + wc * 32 + 4 * fq;
#pragma unroll
        for (int ai = 0; ai < 2; ++ai)
#pragma unroll
            for (int m = 0; m < 4; ++m) { const int r = ai * HALF + wr * 64 + m * 16 + fr; const int t = (j - 1) * 256 + r; const int pos = (wc & 1) ? (t & 63) : ((t >> 6) & 63);
                f32x4 cs = (f32x4){1.f, 1.f, 1.f, 1.f}, sn = (f32x4){0.f, 0.f, 0.f, 0.f};
                if (dorope) { cs = *(const f32x4*)(ropec + pos * 16 + 4 * fq); sn = *(const f32x4*)(ropes + pos * 16 + 4 * fq); }
                bf16_t* rowp = O + (size_t)(u.pm * BM + r) * QKVD + col0;
#pragma unroll
                for (int bj = 0; bj < 2; ++bj) { const f32x4 x1 = acc[ai][bj][m][0], x2 = acc[ai][bj][m][1];
                    const f32x4 o1 = x1 * cs - x2 * sn, o2 = x2 * cs + x1 * sn;
                    u32x2 w1, w2; w1.x = cvt_pk_bf16(o1[0], o1[1]); w1.y = cvt_pk_bf16(o1[2], o1[3]); w2.x = cvt_pk_bf16(o2[0], o2[1]); w2.y = cvt_pk_bf16(o2[2], o2[3]);
                    *(u32x2*)(rowp + bj * HALF) = w1; *(u32x2*)(rowp + bj * HALF + 16) = w2; } }
    }
};

template <class Epi, bool ALIGN_EPI, bool GATHER>
__device__ __forceinline__ void gemm_phase(LAS unsigned char* lds, const Gemm g, const Order& S, const Epi& E) {
    const int tid = threadIdx.x, wid = __builtin_amdgcn_readfirstlane(tid >> 6), lane = tid & 63, wr = wid >> 2, wc = wid & 3, fr = lane & 15, fq = lane >> 4;
    const int K = g.K, nt = K / BK;
    unsigned voffA[2], voffB[2]; int RA[2], CA[2];
#pragma unroll
    for (int i = 0; i < 2; ++i) { int R, C; stage_rc(tid * 16 + i * 8192, R, C); const int Rb = Epi::PERM ? ((R & ~31) + perm32(R & 31)) : R;
        voffA[i] = (unsigned)(R * K + C) * 2u; voffB[i] = (unsigned)(Rb * K + C) * 2u; RA[i] = R; CA[i] = C; }
    const size_t kstep = (size_t)(BK * 2);
    const size_t hstep = (size_t)HALF * K * 2;
    const size_t tstep = 2 * hstep;
    const size_t hstepA = GATHER ? 0 : hstep;
    const unsigned ldsw = (unsigned)wid * 1024u;
    const int aoff = lds_byte(wr * 64 + fr, fq * 8), boff = lds_byte(wc * 32 + fr, fq * 8);
#define PG8_SA(b, h) (((b) * 2 + (h)) * HTB)
#define PG8_SB(b, h) ((4 + (b) * 2 + (h)) * HTB)
#define PG8_STAGE(bufoff, gbase, voff) do { _Pragma("unroll") for (int _i = 0; _i < 2; ++_i) \
        __builtin_amdgcn_global_load_lds((const unsigned*)((const char*)(gbase) + (voff)[_i]), (LAS unsigned*)(lds + (bufoff) + ldsw + _i * 8192), 16, 0, 0); } while (0)
#define PG8_STAGE_A(bufoff, gbase, h, nx) do { if constexpr (GATHER) { unsigned _vo[2]; _vo[0] = (nx) ? gn[h][0] : gc[h][0]; _vo[1] = (nx) ? gn[h][1] : gc[h][1]; PG8_STAGE(bufoff, gbase, _vo); } \
        else { PG8_STAGE(bufoff, (gbase) + (h) * hstep, voffA); } } while (0)
#define PG8_LDA(dst, b, h) do { _Pragma("unroll") for (int m = 0; m < 4; ++m) _Pragma("unroll") for (int k = 0; k < 2; ++k) dst[m][k] = *(const LAS bf16x8*)(lds + PG8_SA(b, h) + aoff + m * 2048 + k * 1024); } while (0)
#define PG8_LDB(dst, b, h) do { _Pragma("unroll") for (int n = 0; n < 2; ++n) _Pragma("unroll") for (int k = 0; k < 2; ++k) dst[n][k] = *(const LAS bf16x8*)(lds + PG8_SB(b, h) + boff + n * 2048 + k * 1024); } while (0)
#define PG8_MMA(ai, bj, At, Bt) do { __builtin_amdgcn_s_setprio(1); _Pragma("unroll") for (int m = 0; m < 4; ++m) _Pragma("unroll") for (int n = 0; n < 2; ++n) _Pragma("unroll") for (int k = 0; k < 2; ++k) \
        acc[ai][bj][m][n] = __builtin_amdgcn_mfma_f32_16x16x32_bf16(Bt[n][k], At[m][k], acc[ai][bj][m][n], 0, 0, 0); __builtin_amdgcn_s_setprio(0); } while (0)
#define PG8_WAIT_V(n) asm volatile("s_waitcnt vmcnt(" #n ")" ::: "memory")
#define PG8_WAIT_L(n) asm volatile("s_waitcnt lgkmcnt(" #n ")" ::: "memory")
#define PG8_BAR __builtin_amdgcn_s_barrier()
#define PG8_SCHED __builtin_amdgcn_sched_barrier(0)
    Unit cur, nxt; int ui = 0;
    if (!S.next(0, cur)) return;
    f32x4 acc[2][2][4][2];
#pragma unroll
    for (int a = 0; a < 2; ++a)
#pragma unroll
        for (int b = 0; b < 2; ++b)
#pragma unroll
            for (int m = 0; m < 4; ++m)
#pragma unroll
                for (int n = 0; n < 2; ++n) acc[a][b][m][n] = (f32x4){0.f, 0.f, 0.f, 0.f};
    bf16x8 At[4][2], B0[2][2], B1[2][2];
    unsigned gc[2][2], gn[2][2];
    if constexpr (GATHER) {
#pragma unroll
        for (int h = 0; h < 2; ++h)
#pragma unroll
            for (int i = 0; i < 2; ++i) { gc[h][i] = ((unsigned)g.rowlist[cur.pm * BM + h * HALF + RA[i]] * (unsigned)K + (unsigned)CA[i]) * 2u; gn[h][i] = gc[h][i]; }
    } else {
#pragma unroll
        for (int h = 0; h < 2; ++h)
#pragma unroll
            for (int i = 0; i < 2; ++i) { gc[h][i] = 0u; gn[h][i] = 0u; }
    }
    const char* cA = (const char*)g.A + (GATHER ? (size_t)0 : (size_t)cur.pm * tstep); const char* cB = (const char*)g.Bt + (size_t)cur.pn * tstep;
    PG8_STAGE(PG8_SB(0, 0), cB, voffB); PG8_STAGE(PG8_SB(0, 1), cB + hstep, voffB); PG8_STAGE_A(PG8_SA(0, 0), cA, 0, false); PG8_STAGE_A(PG8_SA(0, 1), cA, 1, false);
    if (wr == 1) PG8_BAR;
    PG8_WAIT_V(2); PG8_BAR;
    PG8_STAGE(PG8_SB(1, 0), cB + kstep, voffB); PG8_STAGE_A(PG8_SA(1, 0), cA + kstep, 0, false); PG8_STAGE(PG8_SB(1, 1), cB + hstep + kstep, voffB);
    PG8_WAIT_V(6); PG8_BAR;
    for (;;) {
        const bool has_next = S.next(ui + 1, nxt);
        const char* nA = GATHER ? cA : (has_next ? (const char*)g.A + (size_t)nxt.pm * tstep : cA); const char* nB = has_next ? (const char*)g.Bt + (size_t)nxt.pn * tstep : cB;
        if constexpr (GATHER) {
            if (has_next) {
#pragma unroll
                for (int h = 0; h < 2; ++h)
#pragma unroll
                    for (int i = 0; i < 2; ++i) gn[h][i] = ((unsigned)g.rowlist[nxt.pm * BM + h * HALF + RA[i]] * (unsigned)K + (unsigned)CA[i]) * 2u;
            }
        }
        for (int t = 0; t < nt; t += 2) {
            const bool last = (t == nt - 2);
            const char* a1 = cA + (size_t)(t + 1) * kstep;
            const char* a2 = last ? nA : cA + (size_t)(t + 2) * kstep; const char* b2 = last ? nB : cB + (size_t)(t + 2) * kstep;
            const char* a3 = a2 + kstep; const char* b3 = b2 + kstep;
            PG8_LDB(B0, 0, 0); PG8_LDB(B1, 0, 1); PG8_SCHED; PG8_LDA(At, 0, 0); PG8_STAGE_A(PG8_SA(1, 1), a1, 1, false);
            PG8_WAIT_V(8); PG8_WAIT_L(0); PG8_BAR; PG8_MMA(0, 0, At, B0); PG8_MMA(0, 1, At, B1); PG8_BAR; PG8_SCHED;
            PG8_LDA(At, 0, 1); PG8_STAGE(PG8_SB(0, 0), b2, voffB); PG8_STAGE(PG8_SB(0, 1), b2 + hstep, voffB); PG8_STAGE_A(PG8_SA(0, 0), a2, 0, last);
            PG8_WAIT_V(8); PG8_WAIT_L(0); PG8_BAR; PG8_MMA(1, 0, At, B0); PG8_MMA(1, 1, At, B1); PG8_BAR; PG8_SCHED;
            PG8_LDB(B0, 1, 0); PG8_LDB(B1, 1, 1); PG8_SCHED; PG8_LDA(At, 1, 0); PG8_STAGE_A(PG8_SA(0, 1), a2, 1, last);
            PG8_WAIT_V(8); PG8_WAIT_L(0); PG8_BAR; PG8_MMA(0, 0, At, B0); PG8_MMA(0, 1, At, B1); PG8_BAR; PG8_SCHED;
            PG8_LDA(At, 1, 1); PG8_STAGE(PG8_SB(1, 0), b3, voffB); PG8_STAGE(PG8_SB(1, 1), b3 + hstep, voffB); PG8_STAGE_A(PG8_SA(1, 0), a3, 0, last);
            PG8_WAIT_V(8); PG8_WAIT_L(0); PG8_BAR; PG8_MMA(1, 0, At, B0); PG8_MMA(1, 1, At, B1); PG8_BAR; PG8_SCHED;
        }
        if constexpr (ALIGN_EPI) { if (wr == 0) PG8_BAR; }
        E(acc, cur, wr, wc, fr, fq);
        if (!has_next) break;
#pragma unroll
        for (int a = 0; a < 2; ++a)
#pragma unroll
            for (int b = 0; b < 2; ++b)
#pragma unroll
                for (int m = 0; m < 4; ++m)
#pragma unroll
                    for (int n = 0; n < 2; ++n) acc[a][b][m][n] = (f32x4){0.f, 0.f, 0.f, 0.f};
        cur = nxt; cA = nA; cB = nB; ++ui;
        if constexpr (GATHER) {
#pragma unroll
            for (int h = 0; h < 2; ++h)
#pragma unroll
                for (int i = 0; i < 2; ++i) gc[h][i] = gn[h][i];
        }
        if constexpr (ALIGN_EPI) { if (wr == 1) PG8_BAR; }
    }
    PG8_WAIT_V(0);
    if constexpr (!ALIGN_EPI) { if (wr == 0) PG8_BAR; }
    PG8_BAR;
#undef PG8_SA
#undef PG8_SB
#undef PG8_STAGE
#undef PG8_STAGE_A
#undef PG8_LDA
#undef PG8_LDB
#undef PG8_MMA
#undef PG8_WAIT_V
#undef PG8_WAIT_L
#undef PG8_BAR
#undef PG8_SCHED
}
}

#define XB_TMO      128
#define XB_XCNT(j)  (256  + 64 * (j))
#define XB_XSUB(j)  (1280 + 64 * (j))
#define XB_XGEN(j)  (2304 + 64 * (j))
#define XB_TOP      3328
#define XB_TOPGEN   3392
#define XCD_BAR_WORDS 3456
#define XB_SPIN_CAP (1u << 18)
__device__ __forceinline__ unsigned xb_ld(unsigned* p)              { return __hip_atomic_load(p, __ATOMIC_RELAXED, __HIP_MEMORY_SCOPE_AGENT); }
__device__ __forceinline__ unsigned xb_add(unsigned* p, unsigned v) { return __hip_atomic_fetch_add(p, v, __ATOMIC_RELAXED, __HIP_MEMORY_SCOPE_AGENT); }
__device__ __forceinline__ unsigned xb_xcc_id() { return (unsigned)__builtin_amdgcn_s_getreg((3 << 11) | 20) & 0xFu; }
#define XB_SPIN(cond, bar) do { unsigned _sp = 0; while (cond) { __builtin_amdgcn_s_sleep(1); \
    if ((++_sp & 255u) == 0u) { if (xb_ld(&(bar)[XB_TMO])) break; if (_sp > XB_SPIN_CAP) { atomicAdd(&(bar)[XB_TMO], 1u); break; } } } } while (0)
struct XcdBarrier { unsigned* bar; unsigned x; volatile LAS unsigned* st; };
__device__ __forceinline__ XcdBarrier xcd_barrier_post(unsigned* bar, volatile LAS unsigned* st) {
    XcdBarrier b; b.bar = bar; b.x = xb_xcc_id(); b.st = st;
    if (threadIdx.x == 0) (void)xb_add(&bar[XB_XCNT(b.x)], 1u);
    return b;
}
__device__ __forceinline__ void xcd_barrier_complete(unsigned* bar, unsigned x, unsigned& nloc, unsigned& nx) {
    const unsigned G = gridDim.x * gridDim.y * gridDim.z;
    unsigned sum, cnt, mine, sp = 0u;
    for (;;) {
        sum = 0u; cnt = 0u; mine = 0u;
#pragma unroll
        for (unsigned j = 0; j < 16; ++j) { const unsigned c = xb_ld(&bar[XB_XCNT(j)]); sum += c; cnt += (c > 0u) ? 1u : 0u; mine = (j == x) ? c : mine; }
        if (sum == G) break;
        __builtin_amdgcn_s_sleep(1);
        if ((++sp & 255u) == 0u) { if (xb_ld(&bar[XB_TMO])) break; if (sp > XB_SPIN_CAP) { atomicAdd(&bar[XB_TMO], 1u); break; } }
    }
    nloc = mine > 0u ? mine : 1u; nx = cnt > 0u ? cnt : 1u;
}
__device__ __forceinline__ void xcd_barrier(const XcdBarrier& b) {
    asm volatile("s_waitcnt vmcnt(0)" ::: "memory");
    __syncthreads();
    if (threadIdx.x == 0) {
        unsigned* bar = b.bar;
        __builtin_amdgcn_s_waitcnt(0);
        unsigned nloc = b.st[0], nx = b.st[1];
        if (nloc == 0u) { xcd_barrier_complete(bar, b.x, nloc, nx); b.st[0] = nloc; b.st[1] = nx; }
        const unsigned old = xb_add(&bar[XB_XSUB(b.x)], 1u);
        const unsigned gen = old / nloc;
        if (old + 1u == (gen + 1u) * nloc) {
            __builtin_amdgcn_fence(__ATOMIC_RELEASE, "agent");
            asm volatile("s_waitcnt vmcnt(0)" ::: "memory");
            const unsigned og = xb_add(&bar[XB_TOP], 1u);
            const unsigned tg = og / nx;
            if (og + 1u == (tg + 1u) * nx) xb_add(&bar[XB_TOPGEN], 1u);
            else XB_SPIN(xb_ld(&bar[XB_TOPGEN]) == tg, bar);
            __builtin_amdgcn_fence(__ATOMIC_ACQUIRE, "agent");
            xb_add(&bar[XB_XGEN(b.x)], 1u);
            asm volatile("s_waitcnt vmcnt(0)" ::: "memory");
        } else {
            XB_SPIN(xb_ld(&bar[XB_XGEN(b.x)]) == gen, bar);
            __builtin_amdgcn_fence(__ATOMIC_ACQUIRE, "agent");
            asm volatile("s_waitcnt vmcnt(0)" ::: "memory");
        }
    }
    __syncthreads();
}

struct Args { const float* in[22]; float* out; unsigned char* ws; int ph_lo, ph_hi; };
struct Frame {
    LAS unsigned char* lds;
    int tid, lane, wave, G, bid;
    const float* in[22]; float* out; unsigned char* ws;
};
#define IN_X 0
#define IN_C 1
#define IN_CTX 2
#define IN_CCTX 3
#define IN_MODW 4
#define IN_MODB 5
#define IN_N1G 6
#define IN_N2G 7
#define IN_WIN 8
#define IN_WOUT 9
#define IN_SGUW 10
#define IN_SGUB 11
#define IN_LBL 12
#define IN_HNG 13
#define IN_WQKV 14
#define IN_WAO 15
#define IN_SINK 16
#define IN_RW 17
#define IN_W1 18
#define IN_W3 19
#define IN_W2 20
#define IN_FG 21

__device__ __forceinline__ const float* in_row(const Frame& F, int row) {
    const int b = row / TPS, t = row - b * TPS;
    return (t < CTXL) ? F.in[IN_CTX] + (size_t)(b * CTXL + t) * DM : F.in[IN_X] + (size_t)(b * SEQ + (t - CTXL)) * DM;
}
__device__ __forceinline__ int mod_s(int row) { const int b = row / TPS, t = row - b * TPS; return (t < CTXL) ? 8 : b; }

__device__ __forceinline__ void transpose_item(const float* W, int N, bf16_t* WT, int Kd, int k0, int n0, int drow0, LAS float* scr, int lane) {
#pragma unroll 8
    for (int i = 0; i < 32; ++i) { const int kk = 2 * i + (lane >> 5); scr[kk * 33 + (lane & 31)] = W[(size_t)(k0 + kk) * N + n0 + (lane & 31)]; }
    LDS_WAIT(); asm volatile("" ::: "memory");
    const int c = lane & 7;
#pragma unroll
    for (int j = 0; j < 4; ++j) { const int n = (lane >> 3) + 8 * j; const LAS float* s = scr + (8 * c) * 33 + n;
        u32x4 o; o.x = pk2(s[0 * 33], s[1 * 33]); o.y = pk2(s[2 * 33], s[3 * 33]); o.z = pk2(s[4 * 33], s[5 * 33]); o.w = pk2(s[6 * 33], s[7 * 33]);
        *(u32x4*)(WT + (size_t)(drow0 + n) * Kd + k0 + 8 * c) = o; }
    LDS_WAIT(); asm volatile("" ::: "memory");
}
__device__ __forceinline__ void transpose_dense(const float* W, int K, int N, bf16_t* WT, int item, LAS float* scr, int lane) {
    const int nblk = N / 32, kb = item / nblk, nb = item - kb * nblk;
    transpose_item(W, N, WT, K, 64 * kb, 32 * nb, 32 * nb, scr, lane);
}
__device__ __forceinline__ void expert_item(const Frame& F, int l, int it, LAS float* scr, int lane) {
    const int e = it / 3072, r = it - e * 3072;
    bf16_t* W13 = (bf16_t*)(F.ws + WS_W13) + (size_t)e * 4096 * 1024; bf16_t* W2T = (bf16_t*)(F.ws + WS_W2) + (size_t)e * 1024 * 2048;
    if (r < 2048) { const int which = r >> 10, q = r & 1023; const int kb = q >> 6, nb = q & 63, n0 = 32 * nb;
        const float* W = (which ? F.in[IN_W3] : F.in[IN_W1]) + ((size_t)(l * NE + e)) * 1024 * 2048;
        transpose_item(W, 2048, W13, 1024, 64 * kb, n0, (n0 >> 7) * 256 + which * 128 + (n0 & 127), scr, lane);
    } else { const int q = r - 2048; const int kb = q >> 5, nb = q & 31;
        const float* W = F.in[IN_W2] + ((size_t)(l * NE + e)) * 2048 * 1024;
        transpose_item(W, 1024, W2T, 2048, 64 * kb, 32 * nb, 32 * nb, scr, lane);
    }
}

__device__ __forceinline__ void modulate_store(const f32x4 (&v)[4], float rstd, const float* g, const float* sh, const float* sc, bf16_t* orow, int lane, f32x4 (*hout)[4]) {
#pragma unroll
    for (int j = 0; j < 4; ++j) { const int c = 4 * lane + 256 * j;
        const f32x4 gg = *(const f32x4*)(g + c), s1 = *(const f32x4*)(sc + c), s0 = *(const f32x4*)(sh + c);
        const f32x4 h = v[j] * rstd * gg * (s1 + 1.0f) + s0;
        if (hout) (*hout)[j] = h;
        u32x2 w; w.x = pk2(h[0], h[1]); w.y = pk2(h[2], h[3]); *(u32x2*)(orow + c) = w; }
}
__device__ __forceinline__ float row_rstd(const f32x4 (&v)[4]) {
    float s = 0.f;
#pragma unroll
    for (int j = 0; j < 4; ++j) s += (v[j][0] * v[j][0] + v[j][1] * v[j][1]) + (v[j][2] * v[j][2] + v[j][3] * v[j][3]);
    return 1.0f / sqrtf(wave_sum(s) * (1.0f / DM) + EPS);
}

__device__ __forceinline__ void ph_prologue(Frame& F) {
    float* MOD = (float*)(F.ws + WS_MOD);
    if (F.bid < 192) {
        LAS float* sc = (LAS float*)F.lds;
        for (int i = F.tid; i < 9 * 1024; i += NTHR) { const int s = i >> 10, k = i & 1023; const float cv = (s < 8) ? F.in[IN_C][s * 1024 + k] : F.in[IN_CCTX][k]; sc[i] = silu_f(cv); }
        __syncthreads();
        for (int it = F.bid; it < 192; it += F.G) {
            const int l = it / 96, n0 = (it - l * 96) * 64, kg = F.tid >> 6, col = F.tid & 63;
            const float* W = F.in[IN_MODW] + (size_t)l * 1024 * 6144 + n0 + col;
            float a[9];
#pragma unroll
            for (int s = 0; s < 9; ++s) a[s] = 0.f;
            for (int k = kg * 128; k < kg * 128 + 128; ++k) { const float w = W[(size_t)k * 6144];
#pragma unroll
                for (int s = 0; s < 9; ++s) a[s] += sc[s * 1024 + k] * w; }
            LAS float* red = (LAS float*)(F.lds + 40960);
#pragma unroll
            for (int s = 0; s < 9; ++s) red[(kg * 9 + s) * 64 + col] = a[s];
            __syncthreads();
            for (int i = F.tid; i < 9 * 64; i += NTHR) { const int s = i >> 6, cc = i & 63; float t = 0.f;
#pragma unroll
                for (int q = 0; q < 8; ++q) t += red[(q * 9 + s) * 64 + cc];
                MOD[(size_t)(l * 9 + s) * 6144 + n0 + cc] = t + F.in[IN_MODB][l * 6144 + n0 + cc]; }
            __syncthreads();
        }
    }
    if (F.bid == 255 % F.G) {
        float* rc = (float*)(F.ws + WS_ROPE); float* rs = rc + 1024;
        for (int i = F.tid; i < 1024; i += NTHR) { const int pos = i >> 4, q = i & 15; const float inv = powf(10000.0f, -(float)q / 16.0f); const float ang = (float)pos * inv; rc[i] = cosf(ang); rs[i] = sinf(ang); }
    }
    __syncthreads();
    LAS float* scr = (LAS float*)(F.lds + F.wave * 16384);
    const int gw = F.bid * NWAVES + F.wave, NGW = F.G * NWAVES;
    for (int it = gw; it < 3584; it += NGW) {
        int r = it;
        if (r < 1792) { transpose_dense(F.in[IN_WIN], 1024, ABIN, (bf16_t*)(F.ws + WS_WIN), r, scr, F.lane); continue; } r -= 1792;
        if (r < 512) { transpose_dense(F.in[IN_WOUT], 1024, 1024, (bf16_t*)(F.ws + WS_WOUT), r, scr, F.lane); continue; } r -= 512;
        if (r < 768) { transpose_dense(F.in[IN_WQKV], 1024, QKVD, (bf16_t*)(F.ws + WS_WQKV), r, scr, F.lane); continue; } r -= 768;
        transpose_dense(F.in[IN_WAO], 1024, 1024, (bf16_t*)(F.ws + WS_WAO), r, scr, F.lane);
    }
}
__device__ __forceinline__ void ph_xn0(Frame& F) {
    const float* MOD = (const float*)(F.ws + WS_MOD); bf16_t* XN = (bf16_t*)(F.ws + WS_XN);
    const int gw = F.bid * NWAVES + F.wave, NGW = F.G * NWAVES;
    for (int row = gw; row < MROWS; row += NGW) {
        const float* xr = in_row(F, row); const float* md = MOD + (size_t)mod_s(row) * 6144;
        f32x4 v[4];
#pragma unroll
        for (int j = 0; j < 4; ++j) v[j] = *((const f32x4*)xr + F.lane + 64 * j);
        const float rstd = row_rstd(v);
        modulate_store(v, rstd, F.in[IN_N1G], md, md + 1024, XN + (size_t)row * DM, F.lane, nullptr);
    }
}
__device__ __forceinline__ void scan_unit(Frame& F, int b, int h, int d) {
    const bf16_t* Z = (const bf16_t*)(F.ws + WS_R1);
    float* OD = (float*)(F.ws + WS_R2) + (size_t)d * MROWS * 512;
    LAS float* fs = (LAS float*)F.lds;
    LAS float* qs = fs + 32 * 132;
    LAS float* vs = qs + 32 * 132;
    const int v = F.tid >> 2, kq = F.tid & 3;
    float S[32];
#pragma unroll
    for (int i = 0; i < 32; ++i) S[i] = 0.f;
    const int sk = F.tid & 127;
    const float l0 = F.in[IN_LBL][(0 * 2 + d) * 512 + h * 128 + sk], l1 = F.in[IN_LBL][(1 * 2 + d) * 512 + h * 128 + sk];
    const float lb = 1.0f / (1.0f + __expf(l1 - l0));
    for (int ch = 0; ch < TPS / 32; ++ch) {
        __syncthreads();
#pragma unroll
        for (int j = 0; j < 8; ++j) { const int tok = (F.tid >> 7) + 4 * j; const int p = ch * 32 + tok;
            const int tp = (p < CTXL) ? (d ? (CTXL - 1 - p) : p) : (CTXL + (d ? (SEQ - 1 - (p - CTXL)) : (p - CTXL)));
            const bf16_t* zr = Z + (size_t)(b * TPS + tp) * ABIN + h * 128 + sk;
            const float zq = bf2f(zr[1024]), zf = bf2f(zr[1536 + d * 512]), zi = bf2f(zr[2560]);
            fs[tok * 132 + (sk >> 5) * 33 + (sk & 31)] = lb + (1.0f - lb) * sigmoid_f(zf);
            qs[tok * 132 + (sk >> 5) * 33 + (sk & 31)] = silu_f(zq);
            vs[tok * 128 + sk] = zi; }
        __syncthreads();
        for (int tok = 0; tok < 32; ++tok) {
            const float vv = vs[tok * 128 + v]; float o = 0.f;
            const LAS float* fp = fs + tok * 132 + kq * 33; const LAS float* qp = qs + tok * 132 + kq * 33;
#pragma unroll
            for (int i = 0; i < 32; ++i) { const float f = fp[i]; S[i] = f * S[i] + (1.0f - f) * vv; o += S[i] * qp[i]; }
            o += __shfl_xor(o, 1); o += __shfl_xor(o, 2);
            if (kq == 0) { const int p = ch * 32 + tok; const int tp = (p < CTXL) ? (d ? (CTXL - 1 - p) : p) : (CTXL + (d ? (SEQ - 1 - (p - CTXL)) : (p - CTXL)));
                OD[(size_t)(b * TPS + tp) * 512 + h * 128 + v] = o; }
        }
    }
    __syncthreads();
}
__device__ __forceinline__ void sgu_unit(Frame& F, int b, int cch, int g) {
    const bf16_t* Z = (const bf16_t*)(F.ws + WS_R1); bf16_t* Y = (bf16_t*)(F.ws + WS_Y);
    const int rowbase = b * TPS + cch * 128;
    LAS unsigned char* WS = F.lds;
    LAS unsigned char* VT = F.lds + 128 * 272;
    __syncthreads();
    const float* wsrc = F.in[IN_SGUW] + (size_t)g * 128 * 128;
#pragma unroll
    for (int j = 0; j < 8; ++j) { const int e = (F.tid + NTHR * j) * 4; const int t = e >> 7, s = e & 127; const f32x4 w = *(const f32x4*)(wsrc + e);
        u32x2 o; o.x = pk2(w[0], w[1]); o.y = pk2(w[2], w[3]); *(LAS u32x2*)(WS + t * 272 + s * 2) = o; }
    for (int i = 0; i < 16; ++i) { const int s = F.wave * 16 + i;
        const unsigned zz = *(const unsigned*)(Z + (size_t)(rowbase + s) * ABIN + 512 + g * 128 + 2 * F.lane);
        const float a = gelu_f(bflo(zz)), c = gelu_f(bfhi(zz));
        const float mu = wave_sum(a + c) * (1.0f / 128.0f); const float da = a - mu, dc = c - mu;
        const float var = wave_sum(da * da + dc * dc) * (1.0f / 128.0f); const float rs = 1.0f / sqrtf(var + EPS);
        *(LAS unsigned short*)(VT + (2 * F.lane) * 272 + s * 2) = (unsigned short)f2bf(da * rs);
        *(LAS unsigned short*)(VT + (2 * F.lane + 1) * 272 + s * 2) = (unsigned short)f2bf(dc * rs); }
    __syncthreads();
    const int fr = F.lane & 15, fq = F.lane >> 4, t = F.wave * 16 + fr;
    bf16x8 wf[4];
#pragma unroll
    for (int ks = 0; ks < 4; ++ks) wf[ks] = *(const LAS bf16x8*)(WS + t * 272 + (ks * 32 + fq * 8) * 2);
    const float bsv = F.in[IN_SGUB][g * 128 + t];
    const bf16_t* zu = Z + (size_t)(rowbase + t) * ABIN + g * 128; bf16_t* yo = Y + (size_t)(rowbase + t) * DM + g * 128;
#pragma unroll
    for (int ct = 0; ct < 8; ++ct) {
        f32x4 acc = (f32x4){0.f, 0.f, 0.f, 0.f};
#pragma unroll
        for (int ks = 0; ks < 4; ++ks) { const bf16x8 vf = *(const LAS bf16x8*)(VT + (ct * 16 + fr) * 272 + (ks * 32 + fq * 8) * 2);
            acc = __builtin_amdgcn_mfma_f32_16x16x32_bf16(vf, wf[ks], acc, 0, 0, 0); }
        const int c0 = ct * 16 + 4 * fq;
        const u32x2 uu = *(const u32x2*)(zu + c0);
        const float u0 = gelu_f(bflo(uu.x)), u1 = gelu_f(bfhi(uu.x)), u2 = gelu_f(bflo(uu.y)), u3 = gelu_f(bfhi(uu.y));
        u32x2 o; o.x = pk2(u0 * (acc[0] + bsv), u1 * (acc[1] + bsv)); o.y = pk2(u2 * (acc[2] + bsv), u3 * (acc[3] + bsv));
        *(u32x2*)(yo + c0) = o;
    }
}
__device__ __forceinline__ void ph_hgrn_post(Frame& F) {
    const bf16_t* Z = (const bf16_t*)(F.ws + WS_R1); bf16_t* Y = (bf16_t*)(F.ws + WS_Y);
    const float* OD0 = (const float*)(F.ws + WS_R2); const float* OD1 = OD0 + (size_t)MROWS * 512;
    const int gw = F.bid * NWAVES + F.wave, NGW = F.G * NWAVES;
    for (int it = gw; it < MROWS * 4; it += NGW) { const int row = it >> 2, h = it & 3; const size_t o = (size_t)row * 512 + h * 128 + 2 * F.lane;
        const f32x2 a = *(const f32x2*)(OD0 + o), c = *(const f32x2*)(OD1 + o); const float o0 = a[0] + c[0], o1 = a[1] + c[1];
        const float rs = 1.0f / sqrtf(wave_sum(o0 * o0 + o1 * o1) * (1.0f / 128.0f) + EPS);
        const f32x2 ng = *(const f32x2*)(F.in[IN_HNG] + h * 128 + 2 * F.lane);
        const unsigned zg = *(const unsigned*)(Z + (size_t)row * ABIN + 3072 + h * 128 + 2 * F.lane);
        *(unsigned*)(Y + (size_t)row * DM + 512 + h * 128 + 2 * F.lane) = pk2(o0 * rs * ng[0] * silu_f(bflo(zg)), o1 * rs * ng[1] * silu_f(bfhi(zg))); }
}
__device__ __forceinline__ void ph_norm2_router(Frame& F, int l) {
    const float* MOD = (const float*)(F.ws + WS_MOD) + (size_t)l * 9 * 6144; const float* X = (const float*)(F.ws + WS_X); bf16_t* XN = (bf16_t*)(F.ws + WS_XN); float* AFF = (float*)(F.ws + WS_AFF);
    const float* RW = F.in[IN_RW] + (size_t)l * 1024 * 16;
    const int gw = F.bid * NWAVES + F.wave, NGW = F.G * NWAVES;
    for (int row = gw; row < MROWS; row += NGW) {
        const int t = row % TPS; if (l == 1 && t < CTXL) continue;
        const float* md = MOD + (size_t)mod_s(row) * 6144;
        f32x4 v[4], hh[4];
#pragma unroll
        for (int j = 0; j < 4; ++j) v[j] = *((const f32x4*)(X + (size_t)row * DM) + F.lane + 64 * j);
        const float rstd = row_rstd(v);
        modulate_store(v, rstd, F.in[IN_N2G] + l * 1024, md + 3072, md + 4096, XN + (size_t)row * DM, F.lane, &hh);
        float lg[16];
#pragma unroll
        for (int e = 0; e < 16; ++e) lg[e] = 0.f;
#pragma unroll
        for (int j = 0; j < 4; ++j)
#pragma unroll
            for (int i = 0; i < 4; ++i) { const float* rw = RW + (size_t)(4 * F.lane + 256 * j + i) * 16; const float hv = hh[j][i];
#pragma unroll
                for (int q = 0; q < 4; ++q) { const f32x4 w = *(const f32x4*)(rw + 4 * q); lg[4 * q] += hv * w[0]; lg[4 * q + 1] += hv * w[1]; lg[4 * q + 2] += hv * w[2]; lg[4 * q + 3] += hv * w[3]; } }
        float mx = -INFINITY;
#pragma unroll
        for (int e = 0; e < 16; ++e) { lg[e] = wave_sum(lg[e]); mx = fmaxf(mx, lg[e]); }
        float den = 0.f;
#pragma unroll
        for (int e = 0; e < 16; ++e) { lg[e] = expf(lg[e] - mx); den += lg[e]; }
        float mine = 0.f;
#pragma unroll
        for (int e = 0; e < 16; ++e) mine = (F.lane == e) ? lg[e] : mine;
        if (F.lane < 16) AFF[(size_t)row * 16 + F.lane] = mine / den;
    }
}
__device__ __forceinline__ void topk_task(Frame& F, int e, int rowbase, int n, int cap, int slot0, int rpe) {
    const float* AFF = (const float*)(F.ws + WS_AFF); int* SLOT = (int*)(F.ws + WS_SLOT); int* RL = (int*)(F.ws + WS_RLIST);
    LAS unsigned* sh = (LAS unsigned*)F.lds;
    unsigned key[8];
#pragma unroll
    for (int i = 0; i < 8; ++i) { const int idx = F.tid * 8 + i; key[i] = (idx < n) ? __float_as_uint(AFF[(size_t)(rowbase + idx) * 16 + e]) : 0u; }
    unsigned prefix = 0u, kk = (unsigned)cap;
    __syncthreads();
#pragma unroll
    for (int pass = 0; pass < 4; ++pass) {
        const int shift = 24 - 8 * pass;
        if (F.tid < 256) sh[F.tid] = 0u;
        __syncthreads();
#pragma unroll
        for (int i = 0; i < 8; ++i) { const int idx = F.tid * 8 + i; bool ok = idx < n; if (pass > 0) ok = ok && ((key[i] >> (shift + 8)) == (prefix >> (shift + 8)));
            if (ok) (void)__hip_atomic_fetch_add(&sh[(key[i] >> shift) & 255u], 1u, __ATOMIC_RELAXED, __HIP_MEMORY_SCOPE_WORKGROUP); }
        __syncthreads();
        if (F.wave == 0) {
            const unsigned h0 = sh[4 * F.lane], h1 = sh[4 * F.lane + 1], h2 = sh[4 * F.lane + 2], h3 = sh[4 * F.lane + 3];
            unsigned Ssum = h0 + h1 + h2 + h3;
#pragma unroll
            for (int o = 1; o < 64; o <<= 1) { const unsigned tv = __shfl_down(Ssum, o); if (F.lane + o < 64) Ssum += tv; }
            unsigned Sn = __shfl_down(Ssum, 1); if (F.lane == 63) Sn = 0u;
            if (Ssum >= kk && Sn < kk) {
                unsigned cum = Sn; unsigned bin, knew;
                if (cum + h3 >= kk) { bin = 4 * F.lane + 3; knew = kk - cum; }
                else { cum += h3; if (cum + h2 >= kk) { bin = 4 * F.lane + 2; knew = kk - cum; }
                    else { cum += h2; if (cum + h1 >= kk) { bin = 4 * F.lane + 1; knew = kk - cum; } else { cum += h1; bin = 4 * F.lane; knew = kk - cum; } } }
                sh[256] = bin; sh[257] = knew;
            }
        }
        __syncthreads();
        prefix |= sh[256] << shift; kk = sh[257];
        __syncthreads();
    }
    const unsigned T = prefix, krem = kk;
    unsigned cg = 0u, ce = 0u;
#pragma unroll
    for (int i = 0; i < 8; ++i) { const int idx = F.tid * 8 + i; if (idx < n) { cg += (key[i] > T) ? 1u : 0u; ce += (key[i] == T) ? 1u : 0u; } }
    const unsigned packed = cg | (ce << 16); unsigned incl = packed;
#pragma unroll
    for (int o = 1; o < 64; o <<= 1) { const unsigned tv = __shfl_up(incl, o); if (F.lane >= o) incl += tv; }
    if (F.lane == 63) sh[300 + F.wave] = incl;
    __syncthreads();
    unsigned wp = 0u;
#pragma unroll
    for (int w = 0; w < 8; ++w) wp += (w < F.wave) ? sh[300 + w] : 0u;
    const unsigned excl = incl - packed + wp;
    unsigned gtb = excl & 0xffffu, eqb = excl >> 16;
#pragma unroll
    for (int i = 0; i < 8; ++i) { const int idx = F.tid * 8 + i;
        if (idx < n) { const int row = rowbase + idx; int slot = -1;
            if (key[i] > T) { slot = (int)(gtb + (eqb < krem ? eqb : krem)); ++gtb; }
            else if (key[i] == T) { if (eqb < krem) slot = (int)(gtb + eqb); ++eqb; }
            SLOT[(size_t)row * 16 + e] = (slot >= 0) ? (slot0 + slot) : -1;
            if (slot >= 0) RL[e * rpe + slot0 + slot] = row; } }
    __syncthreads();
}
__device__ __forceinline__ void ph_topk(Frame& F, int l) {
    const int ntask = (l == 0) ? 256 : 128, rpe = (l == 0) ? 4352 : 4096;
    for (int it = F.bid; it < ntask; it += F.G) {
        if (it < 128) { const int b = it >> 4, e = it & 15; topk_task(F, e, b * TPS + CTXL, SEQ, CAP_LAT, b * CAP_LAT, rpe); }
        else { const int q = it - 128, b = q >> 4, e = q & 15; topk_task(F, e, b * TPS, CTXL, CAP_CTX, NB * CAP_LAT + b * CAP_CTX, rpe); }
    }
}
__device__ __forceinline__ void ph_combine(Frame& F, int l) {
    const float* MODl = (const float*)(F.ws + WS_MOD) + (size_t)l * 9 * 6144; float* X = (float*)(F.ws + WS_X); bf16_t* XN = (bf16_t*)(F.ws + WS_XN);
    const float* AFF = (const float*)(F.ws + WS_AFF); const int* SLOT = (const int*)(F.ws + WS_SLOT); const bf16_t* YE = (const bf16_t*)(F.ws + WS_R2);
    const int rpe = (l == 0) ? 4352 : 4096;
    const int gw = F.bid * NWAVES + F.wave, NGW = F.G * NWAVES;
    for (int row = gw; row < MROWS; row += NGW) {
        const int b = row / TPS, t = row - b * TPS; if (l == 1 && t < CTXL) continue;
        const float* md = MODl + (size_t)((t < CTXL) ? 8 : b) * 6144;
        f32x4 v[4], a[4];
#pragma unroll
        for (int j = 0; j < 4; ++j) { v[j] = *((const f32x4*)(X + (size_t)row * DM) + F.lane + 64 * j); a[j] = (f32x4){0.f, 0.f, 0.f, 0.f}; }
        for (int e = 0; e < 16; ++e) { const int s = SLOT[(size_t)row * 16 + e];
            if (s >= 0) { const float gt = AFF[(size_t)row * 16 + e]; const bf16_t* yr = YE + ((size_t)e * rpe + s) * DM;
#pragma unroll
                for (int j = 0; j < 4; ++j) { const u32x2 w = *(const u32x2*)(yr + 4 * F.lane + 256 * j); a[j][0] += gt * bflo(w.x); a[j][1] += gt * bfhi(w.x); a[j][2] += gt * bflo(w.y); a[j][3] += gt * bfhi(w.y); } } }
        const float gm = (DBG_SKIP & (l == 0 ? 2 : 8)) ? 0.f : 1.f;
#pragma unroll
        for (int j = 0; j < 4; ++j) { const f32x4 g2 = *(const f32x4*)(md + 5 * 1024 + 4 * F.lane + 256 * j); v[j] = v[j] + g2 * a[j] * gm; }
        const float rstd = row_rstd(v);
        if (l == 0) {
#pragma unroll
            for (int j = 0; j < 4; ++j) *((f32x4*)(X + (size_t)row * DM) + F.lane + 64 * j) = v[j];
            const float* md1 = (const float*)(F.ws + WS_MOD) + (size_t)(9 + ((t < CTXL) ? 8 : b)) * 6144;
            modulate_store(v, rstd, F.in[IN_N1G] + 1024, md1, md1 + 1024, XN + (size_t)row * DM, F.lane, nullptr);
        } else {
            float* orow = F.out + (size_t)(b * SEQ + (t - CTXL)) * DM;
#pragma unroll
            for (int j = 0; j < 4; ++j) { const f32x4 fg = *(const f32x4*)(F.in[IN_FG] + 4 * F.lane + 256 * j); *((f32x4*)orow + F.lane + 64 * j) = v[j] * rstd * fg; }
        }
    }
}
__device__ __forceinline__ unsigned cvtpk(float lo, float hi) { typedef __bf16 bf2 __attribute__((ext_vector_type(2))); f32x2 v = {lo, hi}; bf2 b = __builtin_convertvector(v, bf2); return __builtin_bit_cast(unsigned, b); }
__device__ __forceinline__ void attn_unit(Frame& F, int b, int kvh, int qb) {
    const bf16_t* QKV = (const bf16_t*)(F.ws + WS_R1); bf16_t* O = (bf16_t*)(F.ws + WS_Y);
    LAS unsigned char* KL = F.lds;
    LAS unsigned char* VT = F.lds + 9216;
    const int r = F.lane & 31, h = F.lane >> 5, g = F.wave >> 1, qh = F.wave & 1, hq = kvh * 4 + g;
    const size_t rowlat0 = (size_t)b * TPS + CTXL;
    const int q0 = qb * 128 + qh * 64;
    bf16x8 qf[2][4];
#pragma unroll
    for (int sub = 0; sub < 2; ++sub)
#pragma unroll
        for (int ks = 0; ks < 4; ++ks) qf[sub][ks] = *(const bf16x8*)(QKV + (rowlat0 + q0 + sub * 32 + r) * QKVD + hq * 64 + ks * 16 + h * 8);
    const float c2 = 0.125f * 1.4426950408889634f;
    float mrun[2], lrun[2]; f32x16 o[2][2];
#pragma unroll
    for (int sub = 0; sub < 2; ++sub) { mrun[sub] = F.in[IN_SINK][hq] * 1.4426950408889634f; lrun[sub] = (h == 0) ? 1.f : 0.f;
#pragma unroll
        for (int db = 0; db < 2; ++db)
#pragma unroll
            for (int i = 0; i < 16; ++i) o[sub][db][i] = 0.f; }
    for (int c = 0; c < 10; ++c) {
        const bool local = c < 6; int j0 = 0, krow0;
        if (local) { j0 = qb * 128 - 128 + c * 64; if (j0 < 0 || j0 >= SEQ) continue; krow0 = b * TPS + CTXL + j0; } else krow0 = b * TPS + (c - 6) * 64;
        __syncthreads();
        { const int kv = F.tid >> 3, pc = F.tid & 7;
          const bf16_t* kp = QKV + (size_t)(krow0 + kv) * QKVD + 1024 + kvh * 64 + pc * 8;
          const u32x4 kk = *(const u32x4*)kp; *(LAS u32x4*)(KL + kv * 144 + pc * 16) = kk;
          const u32x4 vv = *(const u32x4*)(kp + 256);
#pragma unroll
          for (int i = 0; i < 8; ++i) { const unsigned w = vv[i >> 1]; *(LAS unsigned short*)(VT + (pc * 8 + i) * 136 + kv * 2) = (unsigned short)((i & 1) ? (w >> 16) : (w & 0xffffu)); } }
        __syncthreads();
#pragma unroll
        for (int sub = 0; sub < 2; ++sub) {
            if (local) { const int orel = qh * 64 + sub * 32, cs = 64 * c; if (!(cs <= orel + 287 && cs + 63 >= orel)) continue; }
            f32x16 s[2];
#pragma unroll
            for (int kb = 0; kb < 2; ++kb) {
#pragma unroll
                for (int i = 0; i < 16; ++i) s[kb][i] = 0.f;
#pragma unroll
                for (int ks = 0; ks < 4; ++ks) { const bf16x8 kf = *(const LAS bf16x8*)(KL + (kb * 32 + r) * 144 + (ks * 16 + h * 8) * 2);
                    s[kb] = __builtin_amdgcn_mfma_f32_32x32x16_bf16(kf, qf[sub][ks], s[kb], 0, 0, 0); } }
            const int qi = q0 + sub * 32 + r;
            float mx = -INFINITY;
#pragma unroll
            for (int kb = 0; kb < 2; ++kb)
#pragma unroll
                for (int i = 0; i < 16; ++i) { float val = s[kb][i] * c2;
                    if (local) { const int jj = j0 + kb * 32 + (i & 3) + 8 * (i >> 2) + 4 * h; const int dd = jj - qi; if (dd > 128 || dd < -128) val = -INFINITY; }
                    s[kb][i] = val; mx = fmaxf(mx, val); }
            mx = fmaxf(mx, __shfl_xor(mx, 32));
            const float mn = fmaxf(mrun[sub], mx); const float alpha = exp2f(mrun[sub] - mn); mrun[sub] = mn;
            float ps = 0.f;
#pragma unroll
            for (int kb = 0; kb < 2; ++kb)
#pragma unroll
                for (int i = 0; i < 16; ++i) { const float p = exp2f(s[kb][i] - mn); s[kb][i] = p; ps += p; }
            lrun[sub] = lrun[sub] * alpha + ps;
#pragma unroll
            for (int db = 0; db < 2; ++db)
#pragma unroll
                for (int i = 0; i < 16; ++i) o[sub][db][i] *= alpha;
#pragma unroll
            for (int kb = 0; kb < 2; ++kb)
#pragma unroll
                for (int st = 0; st < 2; ++st) {
                    u32x4 pw; pw.x = cvtpk(s[kb][8 * st], s[kb][8 * st + 1]); pw.y = cvtpk(s[kb][8 * st + 2], s[kb][8 * st + 3]); pw.z = cvtpk(s[kb][8 * st + 4], s[kb][8 * st + 5]); pw.w = cvtpk(s[kb][8 * st + 6], s[kb][8 * st + 7]);
                    const bf16x8 pf = __builtin_bit_cast(bf16x8, pw);
#pragma unroll
                    for (int db = 0; db < 2; ++db) { const LAS unsigned char* vp = VT + (db * 32 + r) * 136 + (kb * 32 + 16 * st + 4 * h) * 2;
                        const s16x4 lo = *(const LAS s16x4*)vp, hi = *(const LAS s16x4*)(vp + 16);
                        const bf16x8 vf = (bf16x8){lo[0], lo[1], lo[2], lo[3], hi[0], hi[1], hi[2], hi[3]};
                        o[sub][db] = __builtin_amdgcn_mfma_f32_32x32x16_bf16(vf, pf, o[sub][db], 0, 0, 0); } }
        }
    }
#pragma unroll
    for (int sub = 0; sub < 2; ++sub) { const float lt = lrun[sub] + __shfl_xor(lrun[sub], 32); const float inv = 1.0f / lt;
        bf16_t* orow = O + (rowlat0 + q0 + sub * 32 + r) * DM + hq * 64;
#pragma unroll
        for (int db = 0; db < 2; ++db)
#pragma unroll
            for (int i4 = 0; i4 < 4; ++i4) { u32x2 w; w.x = cvtpk(o[sub][db][4 * i4] * inv, o[sub][db][4 * i4 + 1] * inv); w.y = cvtpk(o[sub][db][4 * i4 + 2] * inv, o[sub][db][4 * i4 + 3] * inv);
                *(u32x2*)(orow + db * 32 + 8 * i4 + 4 * h) = w; } }
    __syncthreads();
}

__global__ void __launch_bounds__(NTHR, 2) hybrid_fwd(Args args) {
    extern __shared__ __attribute__((aligned(16))) unsigned char lds_raw[];
    Frame F;
    F.lds = (LAS unsigned char*)lds_raw;
    F.tid = threadIdx.x; F.lane = F.tid & 63; F.wave = __builtin_amdgcn_readfirstlane(F.tid >> 6);
    F.G = gridDim.x; F.bid = blockIdx.x;
#pragma unroll
    for (int i = 0; i < 22; ++i) F.in[i] = args.in[i];
    F.out = args.out; F.ws = args.ws;
    volatile LAS unsigned* MISC = (volatile LAS unsigned*)(F.lds + MISC_OFF);
    for (int u = F.tid; u < (LDS_BYTES - LDSCTL_OFF) / 4; u += NTHR) ((LAS unsigned*)(F.lds + LDSCTL_OFF))[u] = 0u;
    __syncthreads();
    unsigned* ctl = (unsigned*)(F.ws + WS_CTL);
    XcdBarrier bar = xcd_barrier_post(ctl + CW_BAR, MISC + 8);
    const int lo = args.ph_lo, hi = args.ph_hi;
#define IN(k) (lo <= (k) && (k) < hi)
#define SEAM(k) do { if (IN(k) && IN((k) + 1)) xcd_barrier(bar); } while (0)
    const float* MOD = (const float*)(F.ws + WS_MOD);

    if (IN(0)) { ph_prologue(F); } SEAM(0);
    if (IN(1)) { ph_xn0(F); } SEAM(1);
    if (IN(2)) {
        pg8::Gemm g{(const bf16_t*)(F.ws + WS_XN), (const bf16_t*)(F.ws + WS_WIN), 1024, nullptr}; pg8::Order S{136, 14, 1, F.G, F.bid, 0, 0, 0};
        pg8::EpiStore E{(bf16_t*)(F.ws + WS_R1), ABIN};
        pg8::gemm_phase<pg8::EpiStore, true, false>(F.lds, g, S, E);
    } SEAM(2);
    if (IN(3)) {
        if (F.bid < 64) { scan_unit(F, F.bid >> 3, (F.bid >> 1) & 3, F.bid & 1); }
        else { const int c = F.bid - 64, nb = F.G - 64;
            for (int u = c; u < NB * 34 * 4; u += nb) { const int g = u & 3, q = u >> 2; sgu_unit(F, q / 34, q % 34, g); }
            __syncthreads();
            LAS float* scr = (LAS float*)(F.lds + F.wave * 16384);
            for (int it = c * NWAVES + F.wave; it < 49152; it += nb * NWAVES) expert_item(F, 0, it, scr, F.lane);
        }
    } SEAM(3);
    if (IN(4)) { ph_hgrn_post(F); } SEAM(4);
    if (IN(5)) {
        pg8::Gemm g{(const bf16_t*)(F.ws + WS_Y), (const bf16_t*)(F.ws + WS_WOUT), 1024, nullptr}; pg8::Order S{136, 4, 1, F.G, F.bid, 0, 0, 0};
        pg8::EpiResid E{F.in[IN_X], F.in[IN_CTX], (float*)(F.ws + WS_X), MOD, 1, (DBG_SKIP & 1) ? 0.f : 1.f};
        pg8::gemm_phase<pg8::EpiResid, true, false>(F.lds, g, S, E);
    } SEAM(5);
    if (IN(6)) { ph_norm2_router(F, 0); } SEAM(6);
    if (IN(7)) { ph_topk(F, 0); } SEAM(7);
    if (IN(8)) {
        pg8::Gemm g{(const bf16_t*)(F.ws + WS_XN), (const bf16_t*)(F.ws + WS_W13), 1024, (const int*)(F.ws + WS_RLIST)}; pg8::Order S{17, 16, 16, F.G, F.bid, 0, 17, 16};
        pg8::EpiSwiglu E{(bf16_t*)(F.ws + WS_R1)};
        pg8::gemm_phase<pg8::EpiSwiglu, true, true>(F.lds, g, S, E);
    } SEAM(8);
    if (IN(9)) {
        pg8::Gemm g{(const bf16_t*)(F.ws + WS_R1), (const bf16_t*)(F.ws + WS_W2), 2048, nullptr}; pg8::Order S{17, 4, 16, F.G, F.bid, 0, 17, 4};
        pg8::EpiStore E{(bf16_t*)(F.ws + WS_R2), DM};
        pg8::gemm_phase<pg8::EpiStore, true, false>(F.lds, g, S, E);
    } SEAM(9);
    if (IN(10)) {
        ph_combine(F, 0);
        __syncthreads();
        LAS float* scr = (LAS float*)(F.lds + F.wave * 16384);
        for (int it = F.bid * NWAVES + F.wave; it < 49152; it += F.G * NWAVES) expert_item(F, 1, it, scr, F.lane);
    } SEAM(10);
    if (IN(11)) {
        pg8::Gemm g{(const bf16_t*)(F.ws + WS_XN), (const bf16_t*)(F.ws + WS_WQKV), 1024, nullptr}; pg8::Order S{136, 6, 1, F.G, F.bid, 0, 0, 0};
        pg8::EpiQkv E{(bf16_t*)(F.ws + WS_R1), (const float*)(F.ws + WS_ROPE), (const float*)(F.ws + WS_ROPE) + 1024};
        pg8::gemm_phase<pg8::EpiQkv, true, false>(F.lds, g, S, E);
    } SEAM(11);
    if (IN(12)) { for (int u = F.bid; u < NB * 4 * 32; u += F.G) attn_unit(F, u >> 7, (u >> 5) & 3, u & 31); } SEAM(12);
    if (IN(13)) {
        pg8::Gemm g{(const bf16_t*)(F.ws + WS_Y), (const bf16_t*)(F.ws + WS_WAO), 1024, nullptr}; pg8::Order S{128, 4, 1, F.G, F.bid, 1, 0, 0};
        pg8::EpiResid E{nullptr, nullptr, (float*)(F.ws + WS_X), MOD + 9 * 6144, 0, (DBG_SKIP & 4) ? 0.f : 1.f};
        pg8::gemm_phase<pg8::EpiResid, true, false>(F.lds, g, S, E);
    } SEAM(13);
    if (IN(14)) { ph_norm2_router(F, 1); } SEAM(14);
    if (IN(15)) { ph_topk(F, 1); } SEAM(15);
    if (IN(16)) {
        pg8::Gemm g{(const bf16_t*)(F.ws + WS_XN), (const bf16_t*)(F.ws + WS_W13), 1024, (const int*)(F.ws + WS_RLIST)}; pg8::Order S{16, 16, 16, F.G, F.bid, 0, 16, 16};
        pg8::EpiSwiglu E{(bf16_t*)(F.ws + WS_R1)};
        pg8::gemm_phase<pg8::EpiSwiglu, true, true>(F.lds, g, S, E);
    } SEAM(16);
    if (IN(17)) {
        pg8::Gemm g{(const bf16_t*)(F.ws + WS_R1), (const bf16_t*)(F.ws + WS_W2), 2048, nullptr}; pg8::Order S{16, 4, 16, F.G, F.bid, 0, 16, 4};
        pg8::EpiStore E{(bf16_t*)(F.ws + WS_R2), DM};
        pg8::gemm_phase<pg8::EpiStore, true, false>(F.lds, g, S, E);
    } SEAM(17);
    if (IN(18)) { ph_combine(F, 1); }
#undef IN
#undef SEAM
}

#ifndef N_SPLIT
#define N_SPLIT 0
#endif
extern "C" void kernel_launch(void* const* d_in, const int* in_sizes, int n_in, void* d_out, int out_size, void* d_ws, size_t ws_size, hipStream_t stream) {
    static int grid = 0;
    if (grid == 0) {
        if (n_in != 22 || out_size != NB * SEQ * DM || ws_size < WS_END) { fprintf(stderr, "kernel_launch: unexpected shapes (n_in %d, out %d, ws %zu)\n", n_in, out_size, ws_size); grid = -1; return; }
        int dev = 0, cus = 0, per_cu = 0;
        if (hipGetDevice(&dev) != hipSuccess || hipDeviceGetAttribute(&cus, hipDeviceAttributeMultiprocessorCount, dev) != hipSuccess) { grid = -1; return; }
        if (hipFuncSetAttribute((const void*)hybrid_fwd, hipFuncAttributeMaxDynamicSharedMemorySize, LDS_BYTES) != hipSuccess) { fprintf(stderr, "kernel_launch: hipFuncSetAttribute failed\n"); grid = -1; return; }
        if (hipOccupancyMaxActiveBlocksPerMultiprocessor(&per_cu, (const void*)hybrid_fwd, NTHR, LDS_BYTES) != hipSuccess || per_cu < 1) { fprintf(stderr, "kernel_launch: occupancy query says %d\n", per_cu); }
        (void)hipGetLastError();
        grid = cus;
        if (grid != 256) fprintf(stderr, "kernel_launch: %d CUs; this kernel is laid out for 256\n", grid);
    }
    if (grid < 0) return;
    (void)hipMemsetAsync((char*)d_ws + WS_CTL, 0, CTL_ZERO_BYTES, stream);
    Args a{};
    for (int i = 0; i < 22; ++i) a.in[i] = (const float*)d_in[i];
    a.out = (float*)d_out; a.ws = (unsigned char*)d_ws;
#if N_SPLIT
    for (int p = 0; p < 19; ++p) { a.ph_lo = p; a.ph_hi = p + 1; hipLaunchKernelGGL(hybrid_fwd, dim3(grid), dim3(NTHR), LDS_BYTES, stream, a); }
#else
    a.ph_lo = 0; a.ph_hi = 19;
    hipLaunchKernelGGL(hybrid_fwd, dim3(grid), dim3(NTHR), LDS_BYTES, stream, a);
#endif
}
```

```cpp
#include <hip/hip_runtime.h>
#include <cstdio>
#include <cstdint>
#include <cmath>

#define LAS __attribute__((address_space(3)))
#define GAS __attribute__((address_space(1)))
typedef unsigned short bf16_t;
typedef short bf16x8 __attribute__((ext_vector_type(8)));
typedef short s16x4 __attribute__((ext_vector_type(4)));
typedef float f32x4 __attribute__((ext_vector_type(4)));
typedef float f32x2 __attribute__((ext_vector_type(2)));
typedef float f32x16 __attribute__((ext_vector_type(16)));
typedef unsigned u32x4 __attribute__((ext_vector_type(4)));
typedef unsigned u32x2 __attribute__((ext_vector_type(2)));
typedef GAS unsigned gu32;

#ifndef PROBE3
#define PROBE3 0
#endif
#ifndef WGM_GROUPED
#define WGM_GROUPED 4
#endif
#define WGMX(ng) (((ng) > 1) ? WGM_GROUPED : 8)
#ifndef TS_LO
#define TS_LO -1
#define TS_HI -1
#endif
#ifndef REP_MASK
#define REP_MASK 0
#endif
#ifndef DBG_SKIP
#define DBG_SKIP 0
#endif

constexpr int NB = 8, SEQ = 4096, CTXL = 256, DM = 1024, TPS = SEQ + CTXL, MROWS = NB * TPS;
constexpr int ABIN = 3584, NE = 16, FF = 2048, QKVD = 1536;
constexpr int CAP_LAT = 512, CAP_CTX = 32;
constexpr float EPS = 1e-6f;
constexpr int NWAVES = 8, NTHR = 512;

constexpr size_t MiB = 1u << 20;
constexpr size_t WS_CTL = 0, CTL_ZERO_BYTES = 1 * MiB;
constexpr size_t WS_MOD = 1 * MiB;
constexpr size_t WS_ROPE = 1 * MiB + 512 * 1024;
constexpr size_t WS_WIN = 2 * MiB;
constexpr size_t WS_WOUT = 9 * MiB;
constexpr size_t WS_WQKV = 11 * MiB;
constexpr size_t WS_WAO = 14 * MiB;
constexpr size_t WS_AFF = 16 * MiB;
constexpr size_t WS_SLOT = 19 * MiB;
constexpr size_t WS_RLIST = 22 * MiB;
constexpr size_t WS_W13 = 24 * MiB;
constexpr size_t WS_W2 = 152 * MiB;
constexpr size_t WS_X = 216 * MiB;
constexpr size_t WS_XN = 352 * MiB;
constexpr size_t WS_Y = 420 * MiB;
constexpr size_t WS_R1 = 488 * MiB;
constexpr size_t WS_R2 = 760 * MiB;
constexpr size_t WS_W2B = 930 * MiB;
constexpr size_t WS_END = 994 * MiB;
constexpr int CW_BAR = 4096;

constexpr int RING_BYTES = 131072;
constexpr int LDSCTL_OFF = RING_BYTES + 17408, MISC_OFF = LDSCTL_OFF + 320;
constexpr int LDS_BYTES = 155648;
static_assert(MISC_OFF + 128 <= LDS_BYTES, "LDS map");

__device__ __forceinline__ unsigned f2bf(float f) { unsigned u = __builtin_bit_cast(unsigned, f); return (u + 0x7fffu + ((u >> 16) & 1u)) >> 16; }
__device__ __forceinline__ unsigned pk2(float lo, float hi) { return f2bf(lo) | (f2bf(hi) << 16); }
__device__ __forceinline__ float bf2f(unsigned b) { return __builtin_bit_cast(float, b << 16); }
__device__ __forceinline__ float bflo(unsigned w) { return __builtin_bit_cast(float, w << 16); }
__device__ __forceinline__ float bfhi(unsigned w) { return __builtin_bit_cast(float, w & 0xffff0000u); }
__device__ __forceinline__ float wave_sum(float v) {
#pragma unroll
    for (int o = 1; o < 64; o <<= 1) v += __shfl_xor(v, o);
    return v;
}
__device__ __forceinline__ float silu_f(float x) { return x / (1.f + __expf(-x)); }
__device__ __forceinline__ float sigmoid_f(float x) { return 1.f / (1.f + __expf(-x)); }
__device__ __forceinline__ float gelu_f(float v) {
    const float av = fabsf(v), t = __builtin_amdgcn_rcpf(av * 0.2316418882f + 1.0f);
    float q = t * 0.5307027145f + (-0.7265760135f); q = q * t + 0.7107068705f; q = q * t + (-0.142248368f); q = q * t + 0.127414796f; q = q * t;
    const float e = __builtin_amdgcn_exp2f((v * v) * (-0.72134752044f));
    const float m = v * (q * e);
    return v < 0.f ? m : v - m;
}
#define LDS_WAIT() asm volatile("s_waitcnt lgkmcnt(0)" ::: "memory")

namespace pg8 {
constexpr int BM = 256, BK = 64, HALF = 128, HTB = HALF * BK * 2, STAGE_BYTES = 8 * HTB, NXCD = 8;
__host__ __device__ __forceinline__ int lds_byte(int r, int c) { const int st = (r >> 4) * 2 + (c >> 5), rr = r & 15, cc = c & 31, ob = rr * 64 + cc * 2; return st * 1024 + (ob ^ (((ob >> 9) & 1) << 5)); }
__host__ __device__ __forceinline__ void stage_rc(int b, int& R, int& C) { const int st = b / 1024, sb = b % 1024, swz = sb ^ (((sb >> 9) & 1) << 5); R = (st >> 1) * 16 + swz / 64; C = (st & 1) * 32 + (swz % 64) / 2; }
__host__ __device__ __forceinline__ int perm32(int rho) { const int n = rho >> 4, i = rho & 15; return 8 * (i >> 2) + 4 * n + (i & 3); }

struct Unit { int pm, pn, pc; };
struct Gemm { const bf16_t* A; const bf16_t* Bt; int K; const int* rowlist; };

struct Order {
    int nM, nN, ngroups, G, c, latonly, amul, bmul, wgm;
    __device__ __forceinline__ bool next(int i, Unit& u) const {
        const int WGM = wgm;
        const int per = nM * nN, nwg = per * ngroups;
        const long L = (long)i * G + c; if (L >= nwg) return false;
        int wgid = (int)L; { const int q = nwg / NXCD, r = nwg % NXCD, xcd = wgid % NXCD, off = wgid / NXCD; wgid = (xcd < r ? xcd * (q + 1) : r * (q + 1) + (xcd - r) * q) + off; }
        const int grp = wgid / per, w = wgid - grp * per;
        const int nig = WGM * nN, gid = w / nig, fm = gid * WGM, gsz = (nM - fm) < WGM ? (nM - fm) : WGM;
        int pm = fm + ((w % nig) % gsz); const int pn = (w % nig) / gsz;
        if (latonly) pm = (pm >> 4) * 17 + 1 + (pm & 15);
        u.pm = grp * amul + pm; u.pn = grp * bmul + pn; u.pc = pn; return true;
    }
};

__device__ __forceinline__ unsigned cvt_pk_bf16(float lo, float hi) { unsigned r; asm volatile("v_cvt_pk_bf16_f32 %0, %1, %2" : "=v"(r) : "v"(lo), "v"(hi)); return r; }

struct EpiStore {
    static constexpr bool PERM = true;
    bf16_t* O; int ldc;
    __device__ __forceinline__ void operator()(const f32x4 (&acc)[2][2][4][2], const Unit& u, int wr, int wc, int fr, int fq) const {
        const int row0 = u.pm * BM + wr * 64 + fr, col0 = u.pc * BM + wc * 32 + 8 * fq;
#pragma unroll
        for (int ai = 0; ai < 2; ++ai)
#pragma unroll
            for (int m = 0; m < 4; ++m) { bf16_t* rowp = O + (size_t)(row0 + ai * HALF + m * 16) * ldc + col0;
#pragma unroll
                for (int bj = 0; bj < 2; ++bj) { const f32x4 v0 = acc[ai][bj][m][0], v1 = acc[ai][bj][m][1];
                    u32x4 w; w.x = cvt_pk_bf16(v0[0], v0[1]); w.y = cvt_pk_bf16(v0[2], v0[3]); w.z = cvt_pk_bf16(v1[0], v1[1]); w.w = cvt_pk_bf16(v1[2], v1[3]);
                    *(u32x4*)(rowp + bj * HALF) = w; } }
    }
};
struct EpiSwiglu {
    static constexpr bool PERM = true;
    bf16_t* O;
    __device__ __forceinline__ void operator()(const f32x4 (&acc)[2][2][4][2], const Unit& u, int wr, int wc, int fr, int fq) const {
        const int row0 = u.pm * BM + wr * 64 + fr, col0 = u.pc * HALF + wc * 32 + 8 * fq;
#pragma unroll
        for (int ai = 0; ai < 2; ++ai)
#pragma unroll
            for (int m = 0; m < 4; ++m) { bf16_t* rowp = O + (size_t)(row0 + ai * HALF + m * 16) * FF + col0;
                float o[8];
#pragma unroll
                for (int n = 0; n < 2; ++n)
#pragma unroll
                    for (int i = 0; i < 4; ++i) { const float a = acc[ai][0][m][n][i], g = acc[ai][1][m][n][i]; o[n * 4 + i] = (a * __builtin_amdgcn_rcpf(1.f + __expf(-a))) * g; }
                u32x4 w; w.x = cvt_pk_bf16(o[0], o[1]); w.y = cvt_pk_bf16(o[2], o[3]); w.z = cvt_pk_bf16(o[4], o[5]); w.w = cvt_pk_bf16(o[6], o[7]);
                *(u32x4*)rowp = w; }
    }
};
struct EpiResid {
    static constexpr bool PERM = false;
    const float* xl; const float* xc; float* X; const float* modl; int fromin; float gmul;
    __device__ __forceinline__ void operator()(const f32x4 (&acc)[2][2][4][2], const Unit& u, int wr, int wc, int fr, int fq) const {
        const int b = u.pm / 17, j = u.pm - b * 17, s = (j == 0) ? 8 : b;
        const float* gate = modl + s * 6144 + 2048;
        const float* src = fromin ? ((j == 0) ? xc + (size_t)(b * CTXL) * DM : xl + (size_t)(b * SEQ + (j - 1) * 256) * DM) : X + (size_t)u.pm * BM * DM;
        float* dst = X + (size_t)u.pm * BM * DM;
        const int col0 = u.pc * BM + wc * 32 + 4 * fq;
        f32x4 gv[2][2];
#pragma unroll
        for (int bj = 0; bj < 2; ++bj)
#pragma unroll
            for (int n = 0; n < 2; ++n) gv[bj][n] = *(const f32x4*)(gate + col0 + bj * HALF + n * 16) * gmul;
#pragma unroll
        for (int ai = 0; ai < 2; ++ai)
#pragma unroll
            for (int m = 0; m < 4; ++m) { const size_t off = (size_t)(ai * HALF + wr * 64 + m * 16 + fr) * DM + col0;
#pragma unroll
                for (int bj = 0; bj < 2; ++bj)
#pragma unroll
                    for (int n = 0; n < 2; ++n) { const f32x4 xs = *(const f32x4*)(src + off + bj * HALF + n * 16); *(f32x4*)(dst + off + bj * HALF + n * 16) = xs + gv[bj][n] * acc[ai][bj][m][n]; } }
    }
};
struct EpiQkv {
    static constexpr bool PERM = false;
    bf16_t* O; const float* ropec; const float* ropes;
    __device__ __forceinline__ void operator()(const f32x4 (&acc)[2][2][4][2], const Unit& u, int wr, int wc, int fr, int fq) const {
        const int b = u.pm / 17, j = u.pm - b * 17;
        const bool dorope = (j != 0) && (u.pc <= 4);
        const float qs = (u.pc < 4) ? 0.18033688011112042f : 1.0f;
        const int col0 = u.pc * BM + wc * 32 + 4 * fq;
#pragma unroll
        for (int ai = 0; ai < 2; ++ai)
#pragma unroll
            for (int m = 0; m < 4; ++m) { const int r = ai * HALF + wr * 64 + m * 16 + fr; const int t = (j - 1) * 256 + r; const int pos = (wc & 1) ? (t & 63) : ((t >> 6) & 63);
                f32x4 cs = (f32x4){1.f, 1.f, 1.f, 1.f}, sn = (f32x4){0.f, 0.f, 0.f, 0.f};
                if (dorope) { cs = *(const f32x4*)(ropec + pos * 16 + 4 * fq); sn = *(const f32x4*)(ropes + pos * 16 + 4 * fq); }
                bf16_t* rowp = O + (size_t)(u.pm * BM + r) * QKVD + col0;
#pragma unroll
                for (int bj = 0; bj < 2; ++bj) { const f32x4 x1 = acc[ai][bj][m][0], x2 = acc[ai][bj][m][1];
                    const f32x4 o1 = (x1 * cs - x2 * sn) * qs, o2 = (x2 * cs + x1 * sn) * qs;
                    u32x2 w1, w2; w1.x = cvt_pk_bf16(o1[0], o1[1]); w1.y = cvt_pk_bf16(o1[2], o1[3]); w2.x = cvt_pk_bf16(o2[0], o2[1]); w2.y = cvt_pk_bf16(o2[2], o2[3]);
                    *(u32x2*)(rowp + bj * HALF) = w1; *(u32x2*)(rowp + bj * HALF + 16) = w2; } }
    }
};

template <class Epi, bool ALIGN_EPI, bool GATHER>
__device__ __forceinline__ void gemm_phase(LAS unsigned char* lds, const Gemm g, const Order& S, const Epi& E) {
    const int tid = threadIdx.x, wid = __builtin_amdgcn_readfirstlane(tid >> 6), lane = tid & 63, wr = wid >> 2, wc = wid & 3, fr = lane & 15, fq = lane >> 4;
    const int K = g.K, nt = K / BK;
    unsigned voffA[2], voffB[2]; int RA[2], CA[2];
#pragma unroll
    for (int i = 0; i < 2; ++i) { int R, C; stage_rc(tid * 16 + i * 8192, R, C); const int Rb = Epi::PERM ? ((R & ~31) + perm32(R & 31)) : R;
        voffA[i] = (unsigned)(R * K + C) * 2u; voffB[i] = (unsigned)(Rb * K + C) * 2u; RA[i] = R; CA[i] = C; }
    const size_t kstep = (size_t)(BK * 2);
    const size_t hstep = (size_t)HALF * K * 2;
    const size_t tstep = 2 * hstep;
    const size_t hstepA = GATHER ? 0 : hstep;
    const unsigned ldsw = (unsigned)wid * 1024u;
    const int aoff = lds_byte(wr * 64 + fr, fq * 8), boff = lds_byte(wc * 32 + fr, fq * 8);
#define PG8_SA(b, h) (((b) * 2 + (h)) * HTB)
#define PG8_SB(b, h) ((4 + (b) * 2 + (h)) * HTB)
#define PG8_STAGE(bufoff, gbase, voff) do { _Pragma("unroll") for (int _i = 0; _i < 2; ++_i) \
        __builtin_amdgcn_global_load_lds((const unsigned*)((const char*)(gbase) + (voff)[_i]), (LAS unsigned*)(lds + (bufoff) + ldsw + _i * 8192), 16, 0, 0); } while (0)
#define PG8_STAGE_A(bufoff, gbase, h, nx) do { if constexpr (GATHER) { unsigned _vo[2]; _vo[0] = (nx) ? gn[h][0] : gc[h][0]; _vo[1] = (nx) ? gn[h][1] : gc[h][1]; PG8_STAGE(bufoff, gbase, _vo); } \
        else { PG8_STAGE(bufoff, (gbase) + (h) * hstep, voffA); } } while (0)
#define PG8_LDA(dst, b, h) do { _Pragma("unroll") for (int m = 0; m < 4; ++m) _Pragma("unroll") for (int k = 0; k < 2; ++k) dst[m][k] = *(const LAS bf16x8*)(lds + PG8_SA(b, h) + aoff + m * 2048 + k * 1024); } while (0)
#define PG8_LDB(dst, b, h) do { _Pragma("unroll") for (int n = 0; n < 2; ++n) _Pragma("unroll") for (int k = 0; k < 2; ++k) dst[n][k] = *(const LAS bf16x8*)(lds + PG8_SB(b, h) + boff + n * 2048 + k * 1024); } while (0)
#define PG8_MMA(ai, bj, At, Bt) do { __builtin_amdgcn_s_setprio(1); _Pragma("unroll") for (int m = 0; m < 4; ++m) _Pragma("unroll") for (int n = 0; n < 2; ++n) _Pragma("unroll") for (int k = 0; k < 2; ++k) \
        acc[ai][bj][m][n] = __builtin_amdgcn_mfma_f32_16x16x32_bf16(Bt[n][k], At[m][k], acc[ai][bj][m][n], 0, 0, 0); __builtin_amdgcn_s_setprio(0); } while (0)
#define PG8_WAIT_V(n) asm volatile("s_waitcnt vmcnt(" #n ")" ::: "memory")
#define PG8_WAIT_L(n) asm volatile("s_waitcnt lgkmcnt(" #n ")" ::: "memory")
#define PG8_BAR __builtin_amdgcn_s_barrier()
#define PG8_SCHED __builtin_amdgcn_sched_barrier(0)
    Unit cur, nxt; int ui = 0;
    if (!S.next(0, cur)) return;
    f32x4 acc[2][2][4][2];
#pragma unroll
    for (int a = 0; a < 2; ++a)
#pragma unroll
        for (int b = 0; b < 2; ++b)
#pragma unroll
            for (int m = 0; m < 4; ++m)
#pragma unroll
                for (int n = 0; n < 2; ++n) acc[a][b][m][n] = (f32x4){0.f, 0.f, 0.f, 0.f};
    bf16x8 At[4][2], B0[2][2], B1[2][2];
    unsigned gc[2][2], gn[2][2];
    LAS int* rl_lds = (LAS int*)(lds + STAGE_BYTES);
    if constexpr (GATHER) {
        { Unit uu; for (int i = 0; S.next(i, uu); ++i) { if (tid < 256) rl_lds[i * 256 + tid] = g.rowlist[uu.pm * BM + tid]; } }
        __syncthreads();
#pragma unroll
        for (int h = 0; h < 2; ++h)
#pragma unroll
            for (int i = 0; i < 2; ++i) { gc[h][i] = ((unsigned)rl_lds[h * HALF + RA[i]] * (unsigned)K + (unsigned)CA[i]) * 2u; gn[h][i] = gc[h][i]; }
    } else {
#pragma unroll
        for (int h = 0; h < 2; ++h)
#pragma unroll
            for (int i = 0; i < 2; ++i) { gc[h][i] = 0u; gn[h][i] = 0u; }
    }
    const char* cA = (const char*)g.A + (GATHER ? (size_t)0 : (size_t)cur.pm * tstep); const char* cB = (const char*)g.Bt + (size_t)cur.pn * tstep;
    PG8_STAGE(PG8_SB(0, 0), cB, voffB); PG8_STAGE(PG8_SB(0, 1), cB + hstep, voffB); PG8_STAGE_A(PG8_SA(0, 0), cA, 0, false); PG8_STAGE_A(PG8_SA(0, 1), cA, 1, false);
    if (wr == 1) PG8_BAR;
    PG8_WAIT_V(2); PG8_BAR;
    PG8_STAGE(PG8_SB(1, 0), cB + kstep, voffB); PG8_STAGE_A(PG8_SA(1, 0), cA + kstep, 0, false); PG8_STAGE(PG8_SB(1, 1), cB + hstep + kstep, voffB);
    PG8_WAIT_V(6); PG8_BAR;
    for (;;) {
        const bool has_next = S.next(ui + 1, nxt);
        const char* nA = GATHER ? cA : (has_next ? (const char*)g.A + (size_t)nxt.pm * tstep : cA); const char* nB = has_next ? (const char*)g.Bt + (size_t)nxt.pn * tstep : cB;
        if constexpr (GATHER) {
            if (has_next) {
#pragma unroll
                for (int h = 0; h < 2; ++h)
#pragma unroll
                    for (int i = 0; i < 2; ++i) gn[h][i] = ((unsigned)rl_lds[(ui + 1) * 256 + h * HALF + RA[i]] * (unsigned)K + (unsigned)CA[i]) * 2u;
            }
        }
        for (int t = 0; t < nt; t += 2) {
            const bool last = (t == nt - 2);
            const char* a1 = cA + (size_t)(t + 1) * kstep;
            const char* a2 = last ? nA : cA + (size_t)(t + 2) * kstep; const char* b2 = last ? nB : cB + (size_t)(t + 2) * kstep;
            const char* a3 = a2 + kstep; const char* b3 = b2 + kstep;
            PG8_LDB(B0, 0, 0); PG8_LDB(B1, 0, 1); PG8_SCHED; PG8_LDA(At, 0, 0); PG8_STAGE_A(PG8_SA(1, 1), a1, 1, false);
            PG8_WAIT_V(8); PG8_WAIT_L(0); PG8_BAR; PG8_MMA(0, 0, At, B0); PG8_MMA(0, 1, At, B1); PG8_BAR; PG8_SCHED;
            PG8_LDA(At, 0, 1); PG8_STAGE(PG8_SB(0, 0), b2, voffB); PG8_STAGE(PG8_SB(0, 1), b2 + hstep, voffB); PG8_STAGE_A(PG8_SA(0, 0), a2, 0, last);
            PG8_WAIT_V(8); PG8_WAIT_L(0); PG8_BAR; PG8_MMA(1, 0, At, B0); PG8_MMA(1, 1, At, B1); PG8_BAR; PG8_SCHED;
            PG8_LDB(B0, 1, 0); PG8_LDB(B1, 1, 1); PG8_SCHED; PG8_LDA(At, 1, 0); PG8_STAGE_A(PG8_SA(0, 1), a2, 1, last);
            PG8_WAIT_V(8); PG8_WAIT_L(0); PG8_BAR; PG8_MMA(0, 0, At, B0); PG8_MMA(0, 1, At, B1); PG8_BAR; PG8_SCHED;
            PG8_LDA(At, 1, 1); PG8_STAGE(PG8_SB(1, 0), b3, voffB); PG8_STAGE(PG8_SB(1, 1), b3 + hstep, voffB); PG8_STAGE_A(PG8_SA(1, 0), a3, 0, last);
            PG8_WAIT_V(8); PG8_WAIT_L(0); PG8_BAR; PG8_MMA(1, 0, At, B0); PG8_MMA(1, 1, At, B1); PG8_BAR; PG8_SCHED;
        }
        if constexpr (ALIGN_EPI) { if (wr == 0) PG8_BAR; }
        E(acc, cur, wr, wc, fr, fq);
        if (!has_next) break;
#pragma unroll
        for (int a = 0; a < 2; ++a)
#pragma unroll
            for (int b = 0; b < 2; ++b)
#pragma unroll
                for (int m = 0; m < 4; ++m)
#pragma unroll
                    for (int n = 0; n < 2; ++n) acc[a][b][m][n] = (f32x4){0.f, 0.f, 0.f, 0.f};
        cur = nxt; cA = nA; cB = nB; ++ui;
        if constexpr (GATHER) {
#pragma unroll
            for (int h = 0; h < 2; ++h)
#pragma unroll
                for (int i = 0; i < 2; ++i) gc[h][i] = gn[h][i];
        }
        if constexpr (ALIGN_EPI) { if (wr == 1) PG8_BAR; }
    }
    PG8_WAIT_V(0);
    if constexpr (!ALIGN_EPI) { if (wr == 0) PG8_BAR; }
    PG8_BAR;
#undef PG8_SA
#undef PG8_SB
#undef PG8_STAGE
#undef PG8_STAGE_A
#undef PG8_LDA
#undef PG8_LDB
#undef PG8_MMA
#undef PG8_WAIT_V
#undef PG8_WAIT_L
#undef PG8_BAR
#undef PG8_SCHED
}
}

#define XB_TMO      128
#define XB_XCNT(j)  (256  + 64 * (j))
#define XB_XSUB(j)  (1280 + 64 * (j))
#define XB_XGEN(j)  (2304 + 64 * (j))
#define XB_TOP      3328
#define XB_TOPGEN   3392
#define XCD_BAR_WORDS 3456
#define XB_SPIN_CAP (1u << 18)
__device__ __forceinline__ unsigned xb_ld(unsigned* p)              { return __hip_atomic_load(p, __ATOMIC_RELAXED, __HIP_MEMORY_SCOPE_AGENT); }
__device__ __forceinline__ unsigned xb_add(unsigned* p, unsigned v) { return __hip_atomic_fetch_add(p, v, __ATOMIC_RELAXED, __HIP_MEMORY_SCOPE_AGENT); }
__device__ __forceinline__ unsigned xb_xcc_id() { return (unsigned)__builtin_amdgcn_s_getreg((3 << 11) | 20) & 0xFu; }
#define XB_SPIN(cond, bar) do { unsigned _sp = 0; while (cond) { __builtin_amdgcn_s_sleep(1); \
    if ((++_sp & 255u) == 0u) { if (xb_ld(&(bar)[XB_TMO])) break; if (_sp > XB_SPIN_CAP) { atomicAdd(&(bar)[XB_TMO], 1u); break; } } } } while (0)
struct XcdBarrier { unsigned* bar; unsigned x; volatile LAS unsigned* st; };
__device__ __forceinline__ XcdBarrier xcd_barrier_post(unsigned* bar, volatile LAS unsigned* st) {
    XcdBarrier b; b.bar = bar; b.x = xb_xcc_id(); b.st = st;
    if (threadIdx.x == 0) (void)xb_add(&bar[XB_XCNT(b.x)], 1u);
    return b;
}
__device__ __forceinline__ void xcd_barrier_complete(unsigned* bar, unsigned x, unsigned& nloc, unsigned& nx) {
    const unsigned G = gridDim.x * gridDim.y * gridDim.z;
    unsigned sum, cnt, mine, sp = 0u;
    for (;;) {
        sum = 0u; cnt = 0u; mine = 0u;
#pragma unroll
        for (unsigned j = 0; j < 16; ++j) { const unsigned c = xb_ld(&bar[XB_XCNT(j)]); sum += c; cnt += (c > 0u) ? 1u : 0u; mine = (j == x) ? c : mine; }
        if (sum == G) break;
        __builtin_amdgcn_s_sleep(1);
        if ((++sp & 255u) == 0u) { if (xb_ld(&bar[XB_TMO])) break; if (sp > XB_SPIN_CAP) { atomicAdd(&bar[XB_TMO], 1u); break; } }
    }
    nloc = mine > 0u ? mine : 1u; nx = cnt > 0u ? cnt : 1u;
}
__device__ __forceinline__ void xcd_barrier(const XcdBarrier& b) {
    asm volatile("s_waitcnt vmcnt(0)" ::: "memory");
    __syncthreads();
    if (threadIdx.x == 0) {
        unsigned* bar = b.bar;
        __builtin_amdgcn_s_waitcnt(0);
        unsigned nloc = b.st[0], nx = b.st[1];
        if (nloc == 0u) { xcd_barrier_complete(bar, b.x, nloc, nx); b.st[0] = nloc; b.st[1] = nx; }
        const unsigned old = xb_add(&bar[XB_XSUB(b.x)], 1u);
        const unsigned gen = old / nloc;
        if (old + 1u == (gen + 1u) * nloc) {
            __builtin_amdgcn_fence(__ATOMIC_RELEASE, "agent");
            asm volatile("s_waitcnt vmcnt(0)" ::: "memory");
            const unsigned og = xb_add(&bar[XB_TOP], 1u);
            const unsigned tg = og / nx;
            if (og + 1u == (tg + 1u) * nx) xb_add(&bar[XB_TOPGEN], 1u);
            else XB_SPIN(xb_ld(&bar[XB_TOPGEN]) == tg, bar);
            __builtin_amdgcn_fence(__ATOMIC_ACQUIRE, "agent");
            xb_add(&bar[XB_XGEN(b.x)], 1u);
            asm volatile("s_waitcnt vmcnt(0)" ::: "memory");
        } else {
            XB_SPIN(xb_ld(&bar[XB_XGEN(b.x)]) == gen, bar);
            __builtin_amdgcn_fence(__ATOMIC_ACQUIRE, "agent");
            asm volatile("s_waitcnt vmcnt(0)" ::: "memory");
        }
    }
    __syncthreads();
}

struct Args { const float* in[22]; float* out; unsigned char* ws; int ph_lo, ph_hi; };
struct Frame {
    LAS unsigned char* lds;
    int tid, lane, wave, G, bid;
    const float* in[22]; float* out; unsigned char* ws;
};
#define IN_X 0
#define IN_C 1
#define IN_CTX 2
#define IN_CCTX 3
#define IN_MODW 4
#define IN_MODB 5
#define IN_N1G 6
#define IN_N2G 7
#define IN_WIN 8
#define IN_WOUT 9
#define IN_SGUW 10
#define IN_SGUB 11
#define IN_LBL 12
#define IN_HNG 13
#define IN_WQKV 14
#define IN_WAO 15
#define IN_SINK 16
#define IN_RW 17
#define IN_W1 18
#define IN_W3 19
#define IN_W2 20
#define IN_FG 21

__device__ __forceinline__ const float* in_row(const Frame& F, int row) {
    const int b = row / TPS, t = row - b * TPS;
    return (t < CTXL) ? F.in[IN_CTX] + (size_t)(b * CTXL + t) * DM : F.in[IN_X] + (size_t)(b * SEQ + (t - CTXL)) * DM;
}
__device__ __forceinline__ int mod_s(int row) { const int b = row / TPS, t = row - b * TPS; return (t < CTXL) ? 8 : b; }

__device__ __forceinline__ void transpose_item(const float* W, int N, bf16_t* WT, int Kd, int k0, int n0, int drow0, LAS float* scr, int lane) {
#pragma unroll 8
    for (int i = 0; i < 32; ++i) { const int kk = 2 * i + (lane >> 5); scr[kk * 33 + (lane & 31)] = W[(size_t)(k0 + kk) * N + n0 + (lane & 31)]; }
    LDS_WAIT(); asm volatile("" ::: "memory");
    const int c = lane & 7;
#pragma unroll
    for (int j = 0; j < 4; ++j) { const int n = (lane >> 3) + 8 * j; const LAS float* s = scr + (8 * c) * 33 + n;
        u32x4 o; o.x = pk2(s[0 * 33], s[1 * 33]); o.y = pk2(s[2 * 33], s[3 * 33]); o.z = pk2(s[4 * 33], s[5 * 33]); o.w = pk2(s[6 * 33], s[7 * 33]);
        *(u32x4*)(WT + (size_t)(drow0 + n) * Kd + k0 + 8 * c) = o; }
    LDS_WAIT(); asm volatile("" ::: "memory");
}
__device__ __forceinline__ void transpose_dense(const float* W, int K, int N, bf16_t* WT, int item, LAS float* scr, int lane) {
    const int nblk = N / 32, kb = item / nblk, nb = item - kb * nblk;
    transpose_item(W, N, WT, K, 64 * kb, 32 * nb, 32 * nb, scr, lane);
}
__device__ __forceinline__ void expert_item(const Frame& F, int l, int it, LAS float* scr, int lane) {
    const int e = it / 3072, r = it - e * 3072;
    bf16_t* W13 = (l ? (bf16_t*)F.out : (bf16_t*)(F.ws + WS_W13)) + (size_t)e * 4096 * 1024; bf16_t* W2T = (bf16_t*)(F.ws + (l ? WS_W2B : WS_W2)) + (size_t)e * 1024 * 2048;
    if (r < 2048) { const int which = r >> 10, q = r & 1023; const int kb = q >> 6, nb = q & 63, n0 = 32 * nb;
        const float* W = (which ? F.in[IN_W3] : F.in[IN_W1]) + ((size_t)(l * NE + e)) * 1024 * 2048;
        transpose_item(W, 2048, W13, 1024, 64 * kb, n0, (n0 >> 7) * 256 + which * 128 + (n0 & 127), scr, lane);
    } else { const int q = r - 2048; const int kb = q >> 5, nb = q & 31;
        const float* W = F.in[IN_W2] + ((size_t)(l * NE + e)) * 2048 * 1024;
        transpose_item(W, 1024, W2T, 2048, 64 * kb, 32 * nb, 32 * nb, scr, lane);
    }
}

__device__ __forceinline__ void conv_range(const Frame& F, int lo, int hi, int nblk, int cidx) {
    LAS float* scr = (LAS float*)(F.lds + F.wave * 16384);
    for (int it = lo + cidx * NWAVES + F.wave; it < hi; it += nblk * NWAVES) { if (it < 49152) expert_item(F, 0, it, scr, F.lane); else expert_item(F, 1, it - 49152, scr, F.lane); }
}
constexpr int CV_G1 = 5000, CV_G2 = 13000, CV_G4 = 13000, CV_G5 = 8000;
__device__ __forceinline__ void modulate_store(const f32x4 (&v)[4], float rstd, const float* g, const float* sh, const float* sc, bf16_t* orow, int lane, f32x4 (*hout)[4]) {
#pragma unroll
    for (int j = 0; j < 4; ++j) { const int c = 4 * lane + 256 * j;
        const f32x4 gg = *(const f32x4*)(g + c), s1 = *(const f32x4*)(sc + c), s0 = *(const f32x4*)(sh + c);
        const f32x4 h = v[j] * rstd * gg * (s1 + 1.0f) + s0;
        if (hout) (*hout)[j] = h;
        u32x2 w; w.x = pk2(h[0], h[1]); w.y = pk2(h[2], h[3]); *(u32x2*)(orow + c) = w; }
}
__device__ __forceinline__ float row_rstd(const f32x4 (&v)[4]) {
    float s = 0.f;
#pragma unroll
    for (int j = 0; j < 4; ++j) s += (v[j][0] * v[j][0] + v[j][1] * v[j][1]) + (v[j][2] * v[j][2] + v[j][3] * v[j][3]);
    return 1.0f / sqrtf(wave_sum(s) * (1.0f / DM) + EPS);
}

__device__ __forceinline__ void ph_prologue(Frame& F) {
    float* MOD = (float*)(F.ws + WS_MOD);
    if (F.bid < 192) {
        LAS float* sc = (LAS float*)F.lds;
        for (int i = F.tid; i < 9 * 1024; i += NTHR) { const int s = i >> 10, k = i & 1023; const float cv = (s < 8) ? F.in[IN_C][s * 1024 + k] : F.in[IN_CCTX][k]; sc[i] = silu_f(cv); }
        __syncthreads();
        for (int it = F.bid; it < 192; it += F.G) {
            const int l = it / 96, n0 = (it - l * 96) * 64, kg = F.tid >> 6, col = F.tid & 63;
            const float* W = F.in[IN_MODW] + (size_t)l * 1024 * 6144 + n0 + col;
            float a[9];
#pragma unroll
            for (int s = 0; s < 9; ++s) a[s] = 0.f;
            for (int k0 = kg * 128; k0 < kg * 128 + 128; k0 += 16) { float wv[16];
#pragma unroll
                for (int kk = 0; kk < 16; ++kk) wv[kk] = W[(size_t)(k0 + kk) * 6144];
#pragma unroll
                for (int kk = 0; kk < 16; ++kk)
#pragma unroll
                    for (int s = 0; s < 9; ++s) a[s] += sc[s * 1024 + k0 + kk] * wv[kk]; }
            LAS float* red = (LAS float*)(F.lds + 40960);
#pragma unroll
            for (int s = 0; s < 9; ++s) red[(kg * 9 + s) * 64 + col] = a[s];
            __syncthreads();
            for (int i = F.tid; i < 9 * 64; i += NTHR) { const int s = i >> 6, cc = i & 63; float t = 0.f;
#pragma unroll
                for (int q = 0; q < 8; ++q) t += red[(q * 9 + s) * 64 + cc];
                MOD[(size_t)(l * 9 + s) * 6144 + n0 + cc] = t + F.in[IN_MODB][l * 6144 + n0 + cc]; }
            __syncthreads();
        }
    }
    if (F.bid == 255 % F.G) {
        float* rc = (float*)(F.ws + WS_ROPE); float* rs = rc + 1024;
        for (int i = F.tid; i < 1024; i += NTHR) { const int pos = i >> 4, q = i & 15; const float inv = powf(10000.0f, -(float)q / 16.0f); const float ang = (float)pos * inv; rc[i] = cosf(ang); rs[i] = sinf(ang); }
    }
    __syncthreads();
    LAS float* scr = (LAS float*)(F.lds + F.wave * 16384);
    const int gw = F.bid * NWAVES + F.wave, NGW = F.G * NWAVES;
    for (int it = gw; it < 3584; it += NGW) {
        int r = it;
        if (r < 1792) { transpose_dense(F.in[IN_WIN], 1024, ABIN, (bf16_t*)(F.ws + WS_WIN), r, scr, F.lane); continue; } r -= 1792;
        if (r < 512) { transpose_dense(F.in[IN_WOUT], 1024, 1024, (bf16_t*)(F.ws + WS_WOUT), r, scr, F.lane); continue; } r -= 512;
        if (r < 768) { transpose_dense(F.in[IN_WQKV], 1024, QKVD, (bf16_t*)(F.ws + WS_WQKV), r, scr, F.lane); continue; } r -= 768;
        transpose_dense(F.in[IN_WAO], 1024, 1024, (bf16_t*)(F.ws + WS_WAO), r, scr, F.lane);
    }
}
__device__ __forceinline__ void ph_xn0(Frame& F) {
    const float* MOD = (const float*)(F.ws + WS_MOD); bf16_t* XN = (bf16_t*)(F.ws + WS_XN);
    const int gw = F.bid * NWAVES + F.wave, NGW = F.G * NWAVES;
    for (int row = gw; row < MROWS; row += NGW) {
        const float* xr = in_row(F, row); const float* md = MOD + (size_t)mod_s(row) * 6144;
        f32x4 v[4];
#pragma unroll
        for (int j = 0; j < 4; ++j) v[j] = *((const f32x4*)xr + F.lane + 64 * j);
        const float rstd = row_rstd(v);
        modulate_store(v, rstd, F.in[IN_N1G], md, md + 1024, XN + (size_t)row * DM, F.lane, nullptr);
    }
}
__device__ __forceinline__ f32x4 mfma16(bf16x8 a, bf16x8 b, f32x4 c) { return __builtin_amdgcn_mfma_f32_16x16x32_bf16(a, b, c, 0, 0, 0); }
__device__ __forceinline__ unsigned cvtpk(float lo, float hi) { typedef __bf16 bf2 __attribute__((ext_vector_type(2))); f32x2 v = {lo, hi}; bf2 b = __builtin_convertvector(v, bf2); return __builtin_bit_cast(unsigned, b); }
__device__ __forceinline__ float fsigmoid(float x) { return __builtin_amdgcn_rcpf(1.0f + __expf(-x)); }
__device__ __forceinline__ int scan_pos(int p, int d) { return (p < CTXL) ? (d ? (CTXL - 1 - p) : p) : (CTXL + (d ? (SEQ - 1 - (p - CTXL)) : (p - CTXL))); }
constexpr size_t WS_HQ = WS_XN, WS_HK = WS_X, WS_HV = WS_X + 68 * MiB, WS_HD = WS_AFF, WS_HA = 896 * MiB;
__device__ __forceinline__ void scan_s1_unit(Frame& F, int u) {
    const int c = u % 68, bhd = u / 68, d = bhd & 1, h = (bhd >> 1) & 3, b = bhd >> 3;
    const bf16_t* Z = (const bf16_t*)(F.ws + WS_R1);
    bf16_t* HA = (bf16_t*)(F.ws + WS_HA) + (size_t)u * 4096;
    bf16_t* HQ = (bf16_t*)(F.ws + WS_HQ) + (size_t)u * 8192; bf16_t* HK = (bf16_t*)(F.ws + WS_HK) + (size_t)u * 8192; bf16_t* HV = (bf16_t*)(F.ws + WS_HV) + (size_t)u * 8192; float* HD = (float*)(F.ws + WS_HD) + (size_t)u * 128;
    LAS unsigned char* L = F.lds;
    constexpr int SC_QM = 0, SC_KM = 17408, SC_A = 60928, SC_TB = 70144, SC_P8 = 72192, SC_QT = 74240;
    LAS float* TB = (LAS float*)(L + SC_TB); LAS float* P8 = (LAS float*)(L + SC_P8);
    const int k = F.tid & 127, I = F.wave >> 1;
    const int fr = F.lane & 15, fq = F.lane >> 4, w = F.wave;
    const float l0 = F.in[IN_LBL][(0 * 2 + d) * 512 + h * 128 + k], l1 = F.in[IN_LBL][(1 * 2 + d) * 512 + h * 128 + k];
    const float lb = __builtin_amdgcn_rcpf(1.0f + __expf(l1 - l0));
    const int kmrow0 = (I == 0) ? 0 : (I == 1) ? 16 : (I == 2) ? 48 : 96;
    float f[16], q[16]; unsigned vb[16];
#pragma unroll
    for (int j = 0; j < 16; ++j) { const int tp = scan_pos(c * 64 + I * 16 + j, d);
        const bf16_t* zr = Z + (size_t)(b * TPS + tp) * ABIN + h * 128 + k;
        const float zq = bf2f(zr[1024]), zf = bf2f(zr[1536 + d * 512]); vb[j] = zr[2560];
        f[j] = lb + (1.0f - lb) * fsigmoid(zf); q[j] = zq * fsigmoid(zq); }
    float tb, pp8;
    { float r = 1.f;
#pragma unroll
      for (int j = 0; j < 16; ++j) { r *= f[j]; if (j == 8) pp8 = r; }
      tb = r; }
    __syncthreads();
    TB[I * 128 + k] = tb; P8[I * 128 + k] = pp8;
    if (F.tid < 9216 / 16) ((LAS u32x4*)(L + SC_A))[F.tid] = (u32x4){0u, 0u, 0u, 0u};
    __syncthreads();
    const float tb0 = TB[k], tb1 = TB[128 + k], tb2 = TB[256 + k], tb3 = TB[384 + k];
    const float p81 = P8[128 + k], p82 = P8[256 + k], p83 = P8[384 + k];
    const float pre = (I == 0) ? 1.f : (I == 1) ? tb0 : (I == 2) ? tb0 * tb1 : tb0 * tb1 * tb2;
    const float suf = (I == 3) ? 1.f : (I == 2) ? tb3 : (I == 1) ? tb2 * tb3 : tb1 * tb2 * tb3;
    if (I == 0) HD[k] = (tb0 * tb1) * (tb2 * tb3);
    { float r = pre;
#pragma unroll
      for (int j = 0; j < 16; j += 2) { r *= f[j]; const float a0 = q[j] * r; r *= f[j + 1]; const float a1 = q[j + 1] * r; const unsigned wv = cvtpk(a0, a1);
          *(LAS unsigned short*)(L + SC_QT + (16 * I + j) * 256 + k * 2) = (unsigned short)(wv & 0xffffu); *(LAS unsigned short*)(L + SC_QT + (16 * I + j + 1) * 256 + k * 2) = (unsigned short)(wv >> 16); } }
    float ss[16];
    { float r = 1.f;
#pragma unroll
      for (int j = 15; j >= 0; --j) { ss[j] = r; r *= f[j]; } }
    { unsigned kw[8], vw[8];
#pragma unroll
      for (int j = 0; j < 8; ++j) { kw[j] = cvtpk((1.0f - f[2 * j]) * ss[2 * j] * suf, (1.0f - f[2 * j + 1]) * ss[2 * j + 1] * suf); vw[j] = vb[2 * j] | (vb[2 * j + 1] << 16); }
      *(u32x4*)(HK + k * 64 + I * 16) = (u32x4){kw[0], kw[1], kw[2], kw[3]}; *(u32x4*)(HK + k * 64 + I * 16 + 8) = (u32x4){kw[4], kw[5], kw[6], kw[7]};
      *(u32x4*)(HV + k * 64 + I * 16) = (u32x4){vw[0], vw[1], vw[2], vw[3]}; *(u32x4*)(HV + k * 64 + I * 16 + 8) = (u32x4){vw[4], vw[5], vw[6], vw[7]};
    }
    float G[16], iG[16];
    G[8] = 1.f; iG[8] = 1.f;
    { float r = 1.f;
#pragma unroll
      for (int j = 9; j < 16; ++j) { r *= f[j]; G[j] = r; iG[j] = __builtin_amdgcn_rcpf(fmaxf(r, 1e-30f)); } }
    { float r = 1.f;
#pragma unroll
      for (int j = 7; j >= 0; --j) { r *= f[j + 1]; iG[j] = r; G[j] = __builtin_amdgcn_rcpf(fmaxf(r, 1e-30f)); } }
#pragma unroll
    for (int j = 0; j < 16; j += 2) {
        const unsigned wq = cvtpk(q[j] * G[j], q[j + 1] * G[j + 1]), wk = cvtpk((1.0f - f[j]) * iG[j], (1.0f - f[j + 1]) * iG[j + 1]);
        *(LAS unsigned short*)(L + SC_QM + (16 * I + j) * 272 + k * 2) = (unsigned short)(wq & 0xffffu); *(LAS unsigned short*)(L + SC_QM + (16 * I + j + 1) * 272 + k * 2) = (unsigned short)(wq >> 16);
        *(LAS unsigned short*)(L + SC_KM + (kmrow0 + 16 * I + j) * 272 + k * 2) = (unsigned short)(wk & 0xffffu); *(LAS unsigned short*)(L + SC_KM + (kmrow0 + 16 * I + j + 1) * 272 + k * 2) = (unsigned short)(wk >> 16); }
    if (I < 3) {
        const float F1 = p81, F2 = (I == 0) ? tb1 * p82 : p82, F3 = (I == 0) ? tb1 * tb2 * p83 : (I == 1) ? tb2 * p83 : p83;
#pragma unroll
        for (int j = 0; j < 16; j += 2) { const float e0 = (1.0f - f[j]) * ss[j], e1 = (1.0f - f[j + 1]) * ss[j + 1];
            if (I == 0) { const unsigned w1 = cvtpk(e0 * F1, e1 * F1);
                *(LAS unsigned short*)(L + SC_KM + (16 + j) * 272 + k * 2) = (unsigned short)(w1 & 0xffffu); *(LAS unsigned short*)(L + SC_KM + (16 + j + 1) * 272 + k * 2) = (unsigned short)(w1 >> 16); }
            if (I <= 1) { const unsigned w2 = cvtpk(e0 * F2, e1 * F2);
                *(LAS unsigned short*)(L + SC_KM + (48 + 16 * I + j) * 272 + k * 2) = (unsigned short)(w2 & 0xffffu); *(LAS unsigned short*)(L + SC_KM + (48 + 16 * I + j + 1) * 272 + k * 2) = (unsigned short)(w2 >> 16); }
            { const unsigned w3 = cvtpk(e0 * F3, e1 * F3);
                *(LAS unsigned short*)(L + SC_KM + (96 + 16 * I + j) * 272 + k * 2) = (unsigned short)(w3 & 0xffffu); *(LAS unsigned short*)(L + SC_KM + (96 + 16 * I + j + 1) * 272 + k * 2) = (unsigned short)(w3 >> 16); } } }
    __syncthreads();
#pragma unroll
    for (int rep = 0; rep < 2; ++rep) { const int pi = w + 8 * rep;
        if (pi < 10) { const int I2 = (pi >= 6) ? 3 : (pi >= 3) ? 2 : (pi >= 1) ? 1 : 0; const int J2 = pi - ((I2 * (I2 + 1)) >> 1);
            const int kr0 = (I2 == 0) ? 0 : (I2 == 1) ? 16 : (I2 == 2) ? 48 : 96;
            f32x4 a = (f32x4){0.f, 0.f, 0.f, 0.f};
#pragma unroll
            for (int ks = 0; ks < 4; ++ks) { const bf16x8 ka = *(const LAS bf16x8*)(L + SC_KM + (kr0 + 16 * J2 + fr) * 272 + (32 * ks + 8 * fq) * 2);
                const bf16x8 qb = *(const LAS bf16x8*)(L + SC_QM + (16 * I2 + fr) * 272 + (32 * ks + 8 * fq) * 2);
                a = mfma16(ka, qb, a); }
            if (I2 == J2) {
#pragma unroll
                for (int i = 0; i < 4; ++i) if (4 * fq + i > fr) a[i] = 0.f; }
            u32x2 t; t.x = cvtpk(a[0], a[1]); t.y = cvtpk(a[2], a[3]);
            *(LAS u32x2*)(L + SC_A + (16 * I2 + fr) * 144 + (16 * J2 + 4 * fq) * 2) = t; } }
    __syncthreads();
    { const int t = F.tid >> 3, cp = F.tid & 7; *(u32x4*)(HA + t * 64 + cp * 8) = *(const LAS u32x4*)(L + SC_A + t * 144 + cp * 16);
      ((u32x4*)HQ)[F.tid] = ((const LAS u32x4*)(L + SC_QT))[F.tid]; ((u32x4*)HQ)[F.tid + NTHR] = ((const LAS u32x4*)(L + SC_QT))[F.tid + NTHR]; }
}
struct S2Stage { u32x4 q0, q1, k0, k1, a0, v0, v1; float d; };
__device__ __forceinline__ void scan_s2_unit(Frame& F, int b, int h, int d) {
    const int bhd = (b * 4 + h) * 2 + d;
    bf16_t* OD = (bf16_t*)(F.ws + WS_R2) + (size_t)d * MROWS * 512;
    const bf16_t* HQ = (const bf16_t*)(F.ws + WS_HQ) + (size_t)bhd * 68 * 8192; const bf16_t* HK = (const bf16_t*)(F.ws + WS_HK) + (size_t)bhd * 68 * 8192; const bf16_t* HV = (const bf16_t*)(F.ws + WS_HV) + (size_t)bhd * 68 * 8192;
    const bf16_t* HA = (const bf16_t*)(F.ws + WS_HA) + (size_t)bhd * 68 * 4096; const float* HD = (const float*)(F.ws + WS_HD) + (size_t)bhd * 68 * 128;
    LAS unsigned char* L = F.lds;
    constexpr int B_QT = 0, B_KT = 17408, B_A = 35840, B_DEC = 45056, B_STRIDE = 45568, OS_OFF = 2 * B_STRIDE;
    const int fr = F.lane & 15, fq = F.lane >> 4, w = F.wave;
    const int id0 = F.tid, id1 = F.tid + NTHR;
    const int qoff0 = (id0 >> 4) * 272 + (id0 & 15) * 16, qoff1 = (id1 >> 4) * 272 + (id1 & 15) * 16;
    const int koff0 = (id0 >> 3) * 144 + (id0 & 7) * 16, koff1 = (id1 >> 3) * 144 + (id1 & 7) * 16;
    const int vidx = (16 * w + fr) * 64 + 8 * fq;
    f32x4 Sacc[8];
#pragma unroll
    for (int T = 0; T < 8; ++T) Sacc[T] = (f32x4){0.f, 0.f, 0.f, 0.f};
#define S2_LOAD(st, cc) do { const u32x4* pq = (const u32x4*)(HQ + (size_t)(cc) * 8192); const u32x4* pk = (const u32x4*)(HK + (size_t)(cc) * 8192); \
        st.q0 = pq[id0]; st.q1 = pq[id1]; st.k0 = pk[id0]; st.k1 = pk[id1]; st.a0 = ((const u32x4*)(HA + (size_t)(cc) * 4096))[id0]; st.d = HD[(size_t)(cc) * 128 + (F.tid & 127)]; \
        st.v0 = *(const u32x4*)(HV + (size_t)(cc) * 8192 + vidx); st.v1 = *(const u32x4*)(HV + (size_t)(cc) * 8192 + vidx + 32); } while (0)
#define S2_WRITE(st, bufo) do { *(LAS u32x4*)(L + (bufo) + B_QT + qoff0) = st.q0; *(LAS u32x4*)(L + (bufo) + B_QT + qoff1) = st.q1; *(LAS u32x4*)(L + (bufo) + B_KT + koff0) = st.k0; *(LAS u32x4*)(L + (bufo) + B_KT + koff1) = st.k1; \
        *(LAS u32x4*)(L + (bufo) + B_A + koff0) = st.a0; if (F.tid < 128) *(LAS float*)(L + (bufo) + B_DEC + F.tid * 4) = st.d; } while (0)
#define S2_ITER(cc, sx, sz) do { if ((cc) < 68) { LAS unsigned char* Lb = L + ((cc) & 1) * B_STRIDE; const int bn = (((cc) + 1) & 1) * B_STRIDE; \
        if ((cc) + 3 < 68) S2_LOAD(sz, (cc) + 3); \
        bf16x8 sb[4]; \
        _Pragma("unroll") for (int u = 0; u < 4; ++u) { u32x4 t; t.x = cvtpk(Sacc[2 * u][0], Sacc[2 * u][1]); t.y = cvtpk(Sacc[2 * u][2], Sacc[2 * u][3]); t.z = cvtpk(Sacc[2 * u + 1][0], Sacc[2 * u + 1][1]); t.w = cvtpk(Sacc[2 * u + 1][2], Sacc[2 * u + 1][3]); sb[u] = __builtin_bit_cast(bf16x8, t); } \
        const bf16x8 vf0 = __builtin_bit_cast(bf16x8, vc0), vf1 = __builtin_bit_cast(bf16x8, vc1); \
        f32x4 o[4]; \
        _Pragma("unroll") for (int tt = 0; tt < 4; ++tt) { const bf16x8 af = *(const LAS bf16x8*)(Lb + B_A + (16 * tt + fr) * 144 + (8 * fq) * 2); o[tt] = mfma16(af, vf0, (f32x4){0.f, 0.f, 0.f, 0.f}); } \
        _Pragma("unroll") for (int tt = 2; tt < 4; ++tt) { const bf16x8 af = *(const LAS bf16x8*)(Lb + B_A + (16 * tt + fr) * 144 + (32 + 8 * fq) * 2); o[tt] = mfma16(af, vf1, o[tt]); } \
        _Pragma("unroll") for (int u = 0; u < 4; ++u) \
            _Pragma("unroll") for (int tt = 0; tt < 4; ++tt) { const LAS unsigned char* qp = Lb + B_QT + (16 * tt + fr) * 272 + (32 * u + 4 * fq) * 2; \
                const s16x4 lo = *(const LAS s16x4*)qp, hi = *(const LAS s16x4*)(qp + 32); \
                o[tt] = mfma16((bf16x8){lo[0], lo[1], lo[2], lo[3], hi[0], hi[1], hi[2], hi[3]}, sb[u], o[tt]); } \
        _Pragma("unroll") for (int T = 0; T < 8; ++T) { const f32x4 dv = *(const LAS f32x4*)(Lb + B_DEC + (16 * T + 4 * fq) * 4); Sacc[T] = Sacc[T] * dv; } \
        _Pragma("unroll") for (int T = 0; T < 8; ++T) { const bf16x8 kf = *(const LAS bf16x8*)(Lb + B_KT + (16 * T + fr) * 144 + (8 * fq) * 2); Sacc[T] = mfma16(kf, vf0, Sacc[T]); } \
        _Pragma("unroll") for (int T = 0; T < 8; ++T) { const bf16x8 kf = *(const LAS bf16x8*)(Lb + B_KT + (16 * T + fr) * 144 + (32 + 8 * fq) * 2); Sacc[T] = mfma16(kf, vf1, Sacc[T]); } \
          \
        _Pragma("unroll") for (int tt = 0; tt < 4; ++tt) _Pragma("unroll") for (int i = 0; i < 4; ++i) *(LAS float*)(osw + ((16 * tt + 4 * fq + i) * 20 + fr) * 4) = o[tt][i]; \
        asm volatile("s_waitcnt lgkmcnt(0)" ::: "memory"); \
        _Pragma("unroll") for (int j = 0; j < 2; ++j) { const int row = (F.lane >> 1) + 32 * j, hf = F.lane & 1; const int tp = scan_pos((cc) * 64 + row, d); \
            const f32x4 oa = *(const LAS f32x4*)(osw + (row * 20 + 8 * hf) * 4), ob = *(const LAS f32x4*)(osw + (row * 20 + 8 * hf + 4) * 4); \
            u32x4 ow; ow.x = cvtpk(oa[0], oa[1]); ow.y = cvtpk(oa[2], oa[3]); ow.z = cvtpk(ob[0], ob[1]); ow.w = cvtpk(ob[2], ob[3]); \
            *(u32x4*)(OD + (size_t)(b * TPS + tp) * 512 + h * 128 + 16 * w + 8 * hf) = ow; } \
        if ((cc) + 1 < 68) { S2_WRITE(sx, bn); vc0 = sx.v0; vc1 = sx.v1; } \
        __syncthreads(); } } while (0)
    LAS unsigned char* osw = L + OS_OFF + w * 5120;
    S2Stage sA, sB, sC; u32x4 vc0, vc1;
    __syncthreads();
    S2_LOAD(sA, 0); S2_WRITE(sA, 0); vc0 = sA.v0; vc1 = sA.v1;
    S2_LOAD(sA, 1); S2_LOAD(sB, 2);
    __syncthreads();
    for (int c = 0; c < 68; c += 3) {
        S2_ITER(c, sA, sC);
        S2_ITER(c + 1, sB, sA);
        S2_ITER(c + 2, sC, sB);
    }
#undef S2_LOAD
#undef S2_WRITE
#undef S2_ITER
}
__device__ __forceinline__ void sgu_unit(Frame& F, int b, int cch, int g, bool stage_w) {
    const bf16_t* Z = (const bf16_t*)(F.ws + WS_R1); bf16_t* Y = (bf16_t*)(F.ws + WS_Y);
    const int rowbase = b * TPS + cch * 128;
    LAS unsigned char* WS = F.lds;
    LAS unsigned char* VT = F.lds + 128 * 272;
    __syncthreads();
    if (stage_w) { const float* wsrc = F.in[IN_SGUW] + (size_t)g * 128 * 128;
#pragma unroll
        for (int j = 0; j < 8; ++j) { const int e = (F.tid + NTHR * j) * 4; const int t = e >> 7, s = e & 127; const f32x4 w = *(const f32x4*)(wsrc + e);
            u32x2 o; o.x = pk2(w[0], w[1]); o.y = pk2(w[2], w[3]); *(LAS u32x2*)(WS + t * 272 + s * 2) = o; } }
    unsigned zzv[16];
#pragma unroll
    for (int i = 0; i < 16; ++i) zzv[i] = *(const unsigned*)(Z + (size_t)(rowbase + F.wave * 16 + i) * ABIN + 512 + g * 128 + 2 * F.lane);
#pragma unroll
    for (int i = 0; i < 16; ++i) { const int s = F.wave * 16 + i;
        const unsigned zz = zzv[i];
        const float a = gelu_f(bflo(zz)), c = gelu_f(bfhi(zz));
        const float mu = wave_sum(a + c) * (1.0f / 128.0f); const float da = a - mu, dc = c - mu;
        const float var = wave_sum(da * da + dc * dc) * (1.0f / 128.0f); const float rs = 1.0f / sqrtf(var + EPS);
        *(LAS unsigned short*)(VT + (2 * F.lane) * 272 + s * 2) = (unsigned short)f2bf(da * rs);
        *(LAS unsigned short*)(VT + (2 * F.lane + 1) * 272 + s * 2) = (unsigned short)f2bf(dc * rs); }
    __syncthreads();
    const int fr = F.lane & 15, fq = F.lane >> 4, t = F.wave * 16 + fr;
    bf16x8 wf[4];
#pragma unroll
    for (int ks = 0; ks < 4; ++ks) wf[ks] = *(const LAS bf16x8*)(WS + t * 272 + (ks * 32 + fq * 8) * 2);
    const float bsv = F.in[IN_SGUB][g * 128 + t];
    const bf16_t* zu = Z + (size_t)(rowbase + t) * ABIN + g * 128; bf16_t* yo = Y + (size_t)(rowbase + t) * DM + g * 128;
#pragma unroll
    for (int ct = 0; ct < 8; ++ct) {
        f32x4 acc = (f32x4){0.f, 0.f, 0.f, 0.f};
#pragma unroll
        for (int ks = 0; ks < 4; ++ks) { const bf16x8 vf = *(const LAS bf16x8*)(VT + (ct * 16 + fr) * 272 + (ks * 32 + fq * 8) * 2);
            acc = __builtin_amdgcn_mfma_f32_16x16x32_bf16(vf, wf[ks], acc, 0, 0, 0); }
        const int c0 = ct * 16 + 4 * fq;
        const u32x2 uu = *(const u32x2*)(zu + c0);
        const float u0 = gelu_f(bflo(uu.x)), u1 = gelu_f(bfhi(uu.x)), u2 = gelu_f(bflo(uu.y)), u3 = gelu_f(bfhi(uu.y));
        u32x2 o; o.x = pk2(u0 * (acc[0] + bsv), u1 * (acc[1] + bsv)); o.y = pk2(u2 * (acc[2] + bsv), u3 * (acc[3] + bsv));
        *(u32x2*)(yo + c0) = o;
    }
}
__device__ __forceinline__ void ph_hgrn_post(Frame& F) {
    const bf16_t* Z = (const bf16_t*)(F.ws + WS_R1); bf16_t* Y = (bf16_t*)(F.ws + WS_Y);
    const bf16_t* OD0 = (const bf16_t*)(F.ws + WS_R2); const bf16_t* OD1 = OD0 + (size_t)MROWS * 512;
    const int gw = F.bid * NWAVES + F.wave, NGW = F.G * NWAVES;
    const f32x4 ng0 = *(const f32x4*)(F.in[IN_HNG] + 8 * F.lane), ng1 = *(const f32x4*)(F.in[IN_HNG] + 8 * F.lane + 4);
    u32x4 an = (u32x4){0u, 0u, 0u, 0u}, cn = an, zn = an;
    if (gw < MROWS) { an = *(const u32x4*)(OD0 + (size_t)gw * 512 + 8 * F.lane); cn = *(const u32x4*)(OD1 + (size_t)gw * 512 + 8 * F.lane); zn = *(const u32x4*)(Z + (size_t)gw * ABIN + 3072 + 8 * F.lane); }
    for (int row = gw; row < MROWS; row += NGW) {
        const u32x4 a = an, c = cn, zg = zn;
        if (row + NGW < MROWS) { const size_t r2 = (size_t)(row + NGW); an = *(const u32x4*)(OD0 + r2 * 512 + 8 * F.lane); cn = *(const u32x4*)(OD1 + r2 * 512 + 8 * F.lane); zn = *(const u32x4*)(Z + r2 * ABIN + 3072 + 8 * F.lane); }
        float o[8]; float ss = 0.f;
#pragma unroll
        for (int j = 0; j < 4; ++j) { o[2 * j] = bflo(a[j]) + bflo(c[j]); o[2 * j + 1] = bfhi(a[j]) + bfhi(c[j]); ss += o[2 * j] * o[2 * j] + o[2 * j + 1] * o[2 * j + 1]; }
#pragma unroll
        for (int m = 1; m < 16; m <<= 1) ss += __shfl_xor(ss, m);
        const float rs = 1.0f / sqrtf(ss * (1.0f / 128.0f) + EPS);
        u32x4 w;
        w.x = cvtpk(o[0] * rs * ng0[0] * silu_f(bflo(zg.x)), o[1] * rs * ng0[1] * silu_f(bfhi(zg.x)));
        w.y = cvtpk(o[2] * rs * ng0[2] * silu_f(bflo(zg.y)), o[3] * rs * ng0[3] * silu_f(bfhi(zg.y)));
        w.z = cvtpk(o[4] * rs * ng1[0] * silu_f(bflo(zg.z)), o[5] * rs * ng1[1] * silu_f(bfhi(zg.z)));
        w.w = cvtpk(o[6] * rs * ng1[2] * silu_f(bflo(zg.w)), o[7] * rs * ng1[3] * silu_f(bfhi(zg.w)));
        *(u32x4*)(Y + (size_t)row * DM + 512 + 8 * F.lane) = w;
    }
}
__device__ __forceinline__ void ph_norm2_router(Frame& F, int l) {
    const float* MOD = (const float*)(F.ws + WS_MOD) + (size_t)l * 9 * 6144; const float* X = (const float*)(F.ws + WS_X); bf16_t* XN = (bf16_t*)(F.ws + WS_XN); float* AFF = (float*)(F.ws + WS_AFF);
    const float* RW = F.in[IN_RW] + (size_t)l * 1024 * 16;
    LAS float* rwT = (LAS float*)F.lds;
    __syncthreads();
    for (int i = F.tid; i < 4096; i += NTHR) { const int col = i >> 2, q = i & 3; const f32x4 w = *(const f32x4*)(RW + (size_t)col * 16 + 4 * q);
        rwT[(4 * q + 0) * 1024 + col] = w[0]; rwT[(4 * q + 1) * 1024 + col] = w[1]; rwT[(4 * q + 2) * 1024 + col] = w[2]; rwT[(4 * q + 3) * 1024 + col] = w[3]; }
    __syncthreads();
    const int gw = F.bid * NWAVES + F.wave, NGW = F.G * NWAVES;
    for (int row = gw; row < MROWS; row += NGW) {
        const int t = row % TPS; if (l == 1 && t < CTXL) continue;
        const float* md = MOD + (size_t)mod_s(row) * 6144;
        f32x4 v[4], hh[4];
#pragma unroll
        for (int j = 0; j < 4; ++j) v[j] = *((const f32x4*)(X + (size_t)row * DM) + F.lane + 64 * j);
        const float rstd = row_rstd(v);
        modulate_store(v, rstd, F.in[IN_N2G] + l * 1024, md + 3072, md + 4096, XN + (size_t)row * DM, F.lane, &hh);
        float lg[16];
#pragma unroll
        for (int e = 0; e < 16; ++e) { float a = 0.f;
#pragma unroll
            for (int j = 0; j < 4; ++j) { const f32x4 w = *(const LAS f32x4*)(rwT + e * 1024 + 4 * F.lane + 256 * j); a += (hh[j][0] * w[0] + hh[j][1] * w[1]) + (hh[j][2] * w[2] + hh[j][3] * w[3]); }
            lg[e] = a; if ((e & 3) == 3) asm volatile("" ::: "memory"); }
        const bool b5 = F.lane & 32, b4 = F.lane & 16, b3 = F.lane & 8, b2 = F.lane & 4;
        float a8[8], a4[4], a2[2];
#pragma unroll
        for (int i = 0; i < 8; ++i) { const float keep = b5 ? lg[i + 8] : lg[i], send = b5 ? lg[i] : lg[i + 8]; a8[i] = keep + __shfl_xor(send, 32); }
#pragma unroll
        for (int i = 0; i < 4; ++i) { const float keep = b4 ? a8[i + 4] : a8[i], send = b4 ? a8[i] : a8[i + 4]; a4[i] = keep + __shfl_xor(send, 16); }
#pragma unroll
        for (int i = 0; i < 2; ++i) { const float keep = b3 ? a4[i + 2] : a4[i], send = b3 ? a4[i] : a4[i + 2]; a2[i] = keep + __shfl_xor(send, 8); }
        float lgt; { const float keep = b2 ? a2[1] : a2[0], send = b2 ? a2[0] : a2[1]; lgt = keep + __shfl_xor(send, 4); }
        lgt += __shfl_xor(lgt, 2); lgt += __shfl_xor(lgt, 1);
        float mx = lgt;
#pragma unroll
        for (int o = 4; o < 64; o <<= 1) mx = fmaxf(mx, __shfl_xor(mx, o));
        const float ex = expf(lgt - mx); float den = ex;
#pragma unroll
        for (int o = 4; o < 64; o <<= 1) den += __shfl_xor(den, o);
        if ((F.lane & 3) == 0) AFF[(size_t)row * 16 + (F.lane >> 2)] = ex / den;
    }
}
__device__ __forceinline__ void topk_task(Frame& F, int e, int rowbase, int n, int cap, int slot0, int rpe) {
    const float* AFF = (const float*)(F.ws + WS_AFF); int* SLOT = (int*)(F.ws + WS_SLOT); int* RL = (int*)(F.ws + WS_RLIST);
    LAS unsigned* sh = (LAS unsigned*)F.lds;
    unsigned key[8];
#pragma unroll
    for (int i = 0; i < 8; ++i) { const int idx = F.tid * 8 + i; key[i] = (idx < n) ? __float_as_uint(AFF[(size_t)(rowbase + idx) * 16 + e]) : 0u; }
    unsigned prefix = 0u, kk = (unsigned)cap;
    __syncthreads();
#pragma unroll
    for (int pass = 0; pass < 4; ++pass) {
        const int shift = 24 - 8 * pass;
        if (F.tid < 256) sh[F.tid] = 0u;
        __syncthreads();
#pragma unroll
        for (int i = 0; i < 8; ++i) { const int idx = F.tid * 8 + i; bool ok = idx < n; if (pass > 0) ok = ok && ((key[i] >> (shift + 8)) == (prefix >> (shift + 8)));
            if (ok) (void)__hip_atomic_fetch_add(&sh[(key[i] >> shift) & 255u], 1u, __ATOMIC_RELAXED, __HIP_MEMORY_SCOPE_WORKGROUP); }
        __syncthreads();
        if (F.wave == 0) {
            const unsigned h0 = sh[4 * F.lane], h1 = sh[4 * F.lane + 1], h2 = sh[4 * F.lane + 2], h3 = sh[4 * F.lane + 3];
            unsigned Ssum = h0 + h1 + h2 + h3;
#pragma unroll
            for (int o = 1; o < 64; o <<= 1) { const unsigned tv = __shfl_down(Ssum, o); if (F.lane + o < 64) Ssum += tv; }
            unsigned Sn = __shfl_down(Ssum, 1); if (F.lane == 63) Sn = 0u;
            if (Ssum >= kk && Sn < kk) {
                unsigned cum = Sn; unsigned bin, knew;
                if (cum + h3 >= kk) { bin = 4 * F.lane + 3; knew = kk - cum; }
                else { cum += h3; if (cum + h2 >= kk) { bin = 4 * F.lane + 2; knew = kk - cum; }
                    else { cum += h2; if (cum + h1 >= kk) { bin = 4 * F.lane + 1; knew = kk - cum; } else { cum += h1; bin = 4 * F.lane; knew = kk - cum; } } }
                sh[256] = bin; sh[257] = knew;
            }
        }
        __syncthreads();
        prefix |= sh[256] << shift; kk = sh[257];
        __syncthreads();
    }
    const unsigned T = prefix, krem = kk;
    unsigned cg = 0u, ce = 0u;
#pragma unroll
    for (int i = 0; i < 8; ++i) { const int idx = F.tid * 8 + i; if (idx < n) { cg += (key[i] > T) ? 1u : 0u; ce += (key[i] == T) ? 1u : 0u; } }
    const unsigned packed = cg | (ce << 16); unsigned incl = packed;
#pragma unroll
    for (int o = 1; o < 64; o <<= 1) { const unsigned tv = __shfl_up(incl, o); if (F.lane >= o) incl += tv; }
    if (F.lane == 63) sh[300 + F.wave] = incl;
    __syncthreads();
    unsigned wp = 0u;
#pragma unroll
    for (int w = 0; w < 8; ++w) wp += (w < F.wave) ? sh[300 + w] : 0u;
    const unsigned excl = incl - packed + wp;
    unsigned gtb = excl & 0xffffu, eqb = excl >> 16;
#pragma unroll
    for (int i = 0; i < 8; ++i) { const int idx = F.tid * 8 + i;
        if (idx < n) { const int row = rowbase + idx; int slot = -1;
            if (key[i] > T) { slot = (int)(gtb + (eqb < krem ? eqb : krem)); ++gtb; }
            else if (key[i] == T) { if (eqb < krem) slot = (int)(gtb + eqb); ++eqb; }
            SLOT[(size_t)row * 16 + e] = (slot >= 0) ? (slot0 + slot) : -1;
            if (slot >= 0) RL[e * rpe + slot0 + slot] = row; } }
    __syncthreads();
}
__device__ __forceinline__ void ph_topk(Frame& F, int l) {
    const int ntask = (l == 0) ? 256 : 128, rpe = (l == 0) ? 4352 : 4096;
    for (int it = F.bid; it < ntask; it += F.G) {
        if (it < 128) { const int b = it >> 4, e = it & 15; topk_task(F, e, b * TPS + CTXL, SEQ, CAP_LAT, b * CAP_LAT, rpe); }
        else { const int q = it - 128, b = q >> 4, e = q & 15; topk_task(F, e, b * TPS, CTXL, CAP_CTX, NB * CAP_LAT + b * CAP_CTX, rpe); }
    }
}
__device__ __forceinline__ void ph_combine(Frame& F, int l) {
    const float* MODl = (const float*)(F.ws + WS_MOD) + (size_t)l * 9 * 6144; float* X = (float*)(F.ws + WS_X); bf16_t* XN = (bf16_t*)(F.ws + WS_XN);
    const float* AFF = (const float*)(F.ws + WS_AFF); const int* SLOT = (const int*)(F.ws + WS_SLOT); const bf16_t* YE = (const bf16_t*)(F.ws + WS_R2);
    const int rpe = (l == 0) ? 4352 : 4096;
    const int gw = F.bid * NWAVES + F.wave, NGW = F.G * NWAVES;
    for (int row = gw; row < MROWS; row += NGW) {
        const int b = row / TPS, t = row - b * TPS; if (l == 1 && t < CTXL) continue;
        const float* md = MODl + (size_t)((t < CTXL) ? 8 : b) * 6144;
        f32x4 v[4], a[4];
#pragma unroll
        for (int j = 0; j < 4; ++j) { v[j] = *((const f32x4*)(X + (size_t)row * DM) + F.lane + 64 * j); a[j] = (f32x4){0.f, 0.f, 0.f, 0.f}; }
        { int sv = -1; float av = 0.f;
          if (F.lane < 16) { sv = SLOT[(size_t)row * 16 + F.lane]; av = AFF[(size_t)row * 16 + F.lane]; }
          unsigned long long m = __ballot(sv >= 0);
          while (m) {
              const int e0 = __builtin_ctzll(m); m &= m - 1; const int s0 = __builtin_amdgcn_readlane(sv, e0); const float g0 = __uint_as_float(__builtin_amdgcn_readlane(__float_as_uint(av), e0));
              const bool two = (m != 0ull); int e1 = e0, s1 = s0; float g1 = 0.f;
              if (two) { e1 = __builtin_ctzll(m); m &= m - 1; s1 = __builtin_amdgcn_readlane(sv, e1); g1 = __uint_as_float(__builtin_amdgcn_readlane(__float_as_uint(av), e1)); }
              const bf16_t* y0 = YE + ((size_t)e0 * rpe + s0) * DM; const bf16_t* y1 = YE + ((size_t)e1 * rpe + s1) * DM;
              u32x2 w0[4], w1[4];
#pragma unroll
              for (int j = 0; j < 4; ++j) { w0[j] = *(const u32x2*)(y0 + 4 * F.lane + 256 * j); w1[j] = *(const u32x2*)(y1 + 4 * F.lane + 256 * j); }
#pragma unroll
              for (int j = 0; j < 4; ++j) { a[j][0] += g0 * bflo(w0[j].x) + g1 * bflo(w1[j].x); a[j][1] += g0 * bfhi(w0[j].x) + g1 * bfhi(w1[j].x); a[j][2] += g0 * bflo(w0[j].y) + g1 * bflo(w1[j].y); a[j][3] += g0 * bfhi(w0[j].y) + g1 * bfhi(w1[j].y); } } }
        const float gm = (DBG_SKIP & (l == 0 ? 2 : 8)) ? 0.f : 1.f;
#pragma unroll
        for (int j = 0; j < 4; ++j) { const f32x4 g2 = *(const f32x4*)(md + 5 * 1024 + 4 * F.lane + 256 * j); v[j] = v[j] + g2 * a[j] * gm; }
        const float rstd = row_rstd(v);
        if (l == 0) {
#pragma unroll
            for (int j = 0; j < 4; ++j) *((f32x4*)(X + (size_t)row * DM) + F.lane + 64 * j) = v[j];
            const float* md1 = (const float*)(F.ws + WS_MOD) + (size_t)(9 + ((t < CTXL) ? 8 : b)) * 6144;
            modulate_store(v, rstd, F.in[IN_N1G] + 1024, md1, md1 + 1024, XN + (size_t)row * DM, F.lane, nullptr);
        } else {
            float* orow = F.out + (size_t)(b * SEQ + (t - CTXL)) * DM;
#pragma unroll
            for (int j = 0; j < 4; ++j) { const f32x4 fg = *(const f32x4*)(F.in[IN_FG] + 4 * F.lane + 256 * j); *((f32x4*)orow + F.lane + 64 * j) = v[j] * rstd * fg; }
        }
    }
}
__device__ __forceinline__ void attn_unit(Frame& F, int b, int kvh, int qb) {
    const bf16_t* QKV = (const bf16_t*)(F.ws + WS_R1); bf16_t* O = (bf16_t*)(F.ws + WS_Y);
    LAS unsigned char* KL = F.lds;
    LAS unsigned char* VT = F.lds + 9216;
    const int r = F.lane & 31, h = F.lane >> 5, g = F.wave >> 1, qh = F.wave & 1, hq = kvh * 4 + g;
    const size_t rowlat0 = (size_t)b * TPS + CTXL;
    const int q0 = qb * 128 + qh * 64;
    bf16x8 qf[2][4];
#pragma unroll
    for (int sub = 0; sub < 2; ++sub)
#pragma unroll
        for (int ks = 0; ks < 4; ++ks) qf[sub][ks] = *(const bf16x8*)(QKV + (rowlat0 + q0 + sub * 32 + r) * QKVD + hq * 64 + ks * 16 + h * 8);
    float mrun[2], lrun[2]; f32x16 o[2][2];
#pragma unroll
    for (int sub = 0; sub < 2; ++sub) { mrun[sub] = F.in[IN_SINK][hq] * 1.4426950408889634f; lrun[sub] = (h == 0) ? 1.f : 0.f;
#pragma unroll
        for (int db = 0; db < 2; ++db)
#pragma unroll
            for (int i = 0; i < 16; ++i) o[sub][db][i] = 0.f; }
    const int kvp = F.tid >> 3, pcs = F.tid & 7;
    constexpr int ABUF = 9216 + 8704;
    u32x4 kreg, vreg;
#define ATT_NEXT(cc) do { ++(cc); while ((cc) < 6 && ((qb * 128 - 128 + (cc) * 64) < 0 || (qb * 128 - 128 + (cc) * 64) >= SEQ)) ++(cc); } while (0)
#define ATT_LOAD(cc) do { const int kr_ = ((cc) < 6) ? (b * TPS + CTXL + qb * 128 - 128 + (cc) * 64) : (b * TPS + ((cc) - 6) * 64); \
        const bf16_t* kp_ = QKV + (size_t)(kr_ + kvp) * QKVD + 1024 + kvh * 64 + pcs * 8; kreg = *(const u32x4*)kp_; vreg = *(const u32x4*)(kp_ + 256); } while (0)
#define ATT_WRITE(bo) do { *(LAS u32x4*)(KL + (bo) + kvp * 144 + pcs * 16) = kreg; \
        _Pragma("unroll") for (int i = 0; i < 8; ++i) { const unsigned w_ = vreg[i >> 1]; *(LAS unsigned short*)(VT + (bo) + (pcs * 8 + i) * 136 + kvp * 2) = (unsigned short)((i & 1) ? (w_ >> 16) : (w_ & 0xffffu)); } } while (0)
    int c = -1; ATT_NEXT(c);
    int c1 = c; ATT_NEXT(c1);
    __syncthreads();
    ATT_LOAD(c); ATT_WRITE(0);
    if (c1 < 10) ATT_LOAD(c1);
    __syncthreads();
    for (int it = 0; c < 10; ++it) {
        const int bo = (it & 1) * ABUF, bn = ((it + 1) & 1) * ABUF;
        const bool local = c < 6; const int j0 = qb * 128 - 128 + c * 64;
        int c2 = c1; if (c1 < 10) ATT_NEXT(c2);
#pragma unroll
        for (int sub = 0; sub < 2; ++sub) {
            const int orel = qh * 64 + sub * 32, cs = 64 * c;
            if (local && !(cs <= orel + 287 && cs + 63 >= orel)) continue;
            const bool needmask = local && !((cs - orel <= 193) && (cs - orel >= 31));
            f32x16 s[2];
#pragma unroll
            for (int kb = 0; kb < 2; ++kb) {
#pragma unroll
                for (int i = 0; i < 16; ++i) s[kb][i] = 0.f;
#pragma unroll
                for (int ks = 0; ks < 4; ++ks) { const bf16x8 kf = *(const LAS bf16x8*)(KL + bo + (kb * 32 + r) * 144 + (ks * 16 + h * 8) * 2);
                    s[kb] = __builtin_amdgcn_mfma_f32_32x32x16_bf16(kf, qf[sub][ks], s[kb], 0, 0, 0); } }
            if (needmask) { const int qi = q0 + sub * 32 + r;
#pragma unroll
                for (int kb = 0; kb < 2; ++kb)
#pragma unroll
                    for (int i = 0; i < 16; ++i) { const int dd = j0 + kb * 32 + (i & 3) + 8 * (i >> 2) + 4 * h - qi; if (dd > 128 || dd < -128) s[kb][i] = -INFINITY; } }
            float mx = fmaxf(s[0][0], s[1][0]);
#pragma unroll
            for (int i = 1; i < 16; ++i) mx = fmaxf(mx, fmaxf(s[0][i], s[1][i]));
            mx = fmaxf(mx, __shfl_xor(mx, 32));
            const float mn = fmaxf(mrun[sub], mx);
            if (__any(mn > mrun[sub])) { const float alpha = __builtin_amdgcn_exp2f(mrun[sub] - mn); lrun[sub] *= alpha;
#pragma unroll
                for (int db = 0; db < 2; ++db)
#pragma unroll
                    for (int i = 0; i < 16; ++i) o[sub][db][i] *= alpha; }
            mrun[sub] = mn;
            float ps = 0.f;
#pragma unroll
            for (int kb = 0; kb < 2; ++kb)
#pragma unroll
                for (int i = 0; i < 16; ++i) { const float p = __builtin_amdgcn_exp2f(s[kb][i] - mn); s[kb][i] = p; ps += p; }
            lrun[sub] += ps;
#pragma unroll
            for (int kb = 0; kb < 2; ++kb)
#pragma unroll
                for (int st = 0; st < 2; ++st) {
                    u32x4 pw; pw.x = cvtpk(s[kb][8 * st], s[kb][8 * st + 1]); pw.y = cvtpk(s[kb][8 * st + 2], s[kb][8 * st + 3]); pw.z = cvtpk(s[kb][8 * st + 4], s[kb][8 * st + 5]); pw.w = cvtpk(s[kb][8 * st + 6], s[kb][8 * st + 7]);
                    const bf16x8 pf = __builtin_bit_cast(bf16x8, pw);
#pragma unroll
                    for (int db = 0; db < 2; ++db) { const LAS unsigned char* vp = VT + bo + (db * 32 + r) * 136 + (kb * 32 + 16 * st + 4 * h) * 2;
                        const s16x4 lo = *(const LAS s16x4*)vp, hi = *(const LAS s16x4*)(vp + 16);
                        const bf16x8 vf = (bf16x8){lo[0], lo[1], lo[2], lo[3], hi[0], hi[1], hi[2], hi[3]};
                        o[sub][db] = __builtin_amdgcn_mfma_f32_32x32x16_bf16(vf, pf, o[sub][db], 0, 0, 0); } }
        }
        if (c1 < 10) { ATT_WRITE(bn); if (c2 < 10) ATT_LOAD(c2); }
        __syncthreads();
        c = c1; c1 = c2;
    }
#pragma unroll
    for (int sub = 0; sub < 2; ++sub) { const float lt = lrun[sub] + __shfl_xor(lrun[sub], 32); const float inv = 1.0f / lt;
        bf16_t* orow = O + (rowlat0 + q0 + sub * 32 + r) * DM + hq * 64;
#pragma unroll
        for (int db = 0; db < 2; ++db)
#pragma unroll
            for (int i4 = 0; i4 < 4; ++i4) { u32x2 w; w.x = cvtpk(o[sub][db][4 * i4] * inv, o[sub][db][4 * i4 + 1] * inv); w.y = cvtpk(o[sub][db][4 * i4 + 2] * inv, o[sub][db][4 * i4 + 3] * inv);
                *(u32x2*)(orow + db * 32 + 8 * i4 + 4 * h) = w; } }
    __syncthreads();
#undef ATT_LOAD
#undef ATT_WRITE
#undef ATT_NEXT
}

__global__ void __launch_bounds__(NTHR, 2) hybrid_fwd(Args args) {
    extern __shared__ __attribute__((aligned(16))) unsigned char lds_raw[];
    Frame F;
    F.lds = (LAS unsigned char*)lds_raw;
    F.tid = threadIdx.x; F.lane = F.tid & 63; F.wave = __builtin_amdgcn_readfirstlane(F.tid >> 6);
    F.G = gridDim.x; F.bid = blockIdx.x;
#pragma unroll
    for (int i = 0; i < 22; ++i) F.in[i] = args.in[i];
    F.out = args.out; F.ws = args.ws;
    volatile LAS unsigned* MISC = (volatile LAS unsigned*)(F.lds + MISC_OFF);
    for (int u = F.tid; u < (LDS_BYTES - LDSCTL_OFF) / 4; u += NTHR) ((LAS unsigned*)(F.lds + LDSCTL_OFF))[u] = 0u;
    __syncthreads();
    unsigned* ctl = (unsigned*)(F.ws + WS_CTL);
    XcdBarrier bar = xcd_barrier_post(ctl + CW_BAR, MISC + 8);
    const int lo = args.ph_lo, hi = args.ph_hi;
#define IN(k) (lo <= (k) && (k) < hi)
#define REPS(k) for (int rep_ = 0; rep_ < (((REP_MASK >> (k)) & 1) ? 2 : 1); ++rep_, (void)((rep_ == 1 && ((REP_MASK >> (k)) & 1)) ? (xcd_barrier(bar), 0) : 0))
#define SEAM(k) do { if (IN(k) && IN((k) + 1)) xcd_barrier(bar); if (TS_HI == (k) && F.bid == 0 && F.tid == 0) ts1 = __builtin_amdgcn_s_memrealtime(); if (TS_LO == (k) + 1 && F.bid == 0 && F.tid == 0) ts0 = __builtin_amdgcn_s_memrealtime(); } while (0)
    const float* MOD = (const float*)(F.ws + WS_MOD);
    unsigned long long ts0 = 0, ts1 = 0;
    if (TS_LO == 0 && F.bid == 0 && F.tid == 0) ts0 = __builtin_amdgcn_s_memrealtime();

    if (IN(0)) REPS(0) { ph_prologue(F); } SEAM(0);
    if (IN(1)) REPS(1) { ph_xn0(F); } SEAM(1);
    if (IN(2)) REPS(2) {
        pg8::Gemm g{(const bf16_t*)(F.ws + WS_XN), (const bf16_t*)(F.ws + WS_WIN), 1024, nullptr}; pg8::Order S{136, 14, 1, F.G, F.bid, 0, 0, 0, WGMX(1)};
        pg8::EpiStore E{(bf16_t*)(F.ws + WS_R1), ABIN};
        pg8::gemm_phase<pg8::EpiStore, true, false>(F.lds, g, S, E);
        if (F.bid >= 112) conv_range(F, 0, CV_G1, F.G - 112, F.bid - 112);
    } SEAM(2);
    if (IN(3)) REPS(3) {
        for (int u = F.bid; u < 64 * 68; u += F.G) scan_s1_unit(F, u);
        __syncthreads();
        for (int u = F.bid; u < NB * 34 * 4; u += F.G) { const int g = u & 3, q = u >> 2; sgu_unit(F, q / 34, q % 34, g, (u == F.bid) || (F.G & 3)); }
        xcd_barrier(bar);
        if (F.bid < 64) { scan_s2_unit(F, F.bid >> 3, (F.bid >> 1) & 3, F.bid & 1); }
        else { const int c = F.bid - 64, nb = F.G - 64;
            conv_range(F, CV_G1 + CV_G2, 49152, nb, c); conv_range(F, 49152 + CV_G4 + CV_G5, 2 * 49152, nb, c);
        }
    } SEAM(3);
    if (IN(4)) REPS(4) { ph_hgrn_post(F); } SEAM(4);
    if (IN(5)) REPS(5) {
        pg8::Gemm g{(const bf16_t*)(F.ws + WS_Y), (const bf16_t*)(F.ws + WS_WOUT), 1024, nullptr}; pg8::Order S{136, 4, 1, F.G, F.bid, 0, 0, 0, WGMX(1)};
        pg8::EpiResid E{F.in[IN_X], F.in[IN_CTX], (float*)(F.ws + WS_X), MOD, 1, (DBG_SKIP & 1) ? 0.f : 1.f};
        pg8::gemm_phase<pg8::EpiResid, true, false>(F.lds, g, S, E);
        if (F.bid >= 32) conv_range(F, CV_G1, CV_G1 + CV_G2, F.G - 32, F.bid - 32);
    } SEAM(5);
    if (IN(6)) REPS(6) { ph_norm2_router(F, 0); } SEAM(6);
    if (IN(7)) REPS(7) { ph_topk(F, 0); } SEAM(7);
    if (IN(8)) REPS(8) {
        pg8::Gemm g{(const bf16_t*)(F.ws + WS_XN), (const bf16_t*)(F.ws + WS_W13), 1024, (const int*)(F.ws + WS_RLIST)}; pg8::Order S{17, 16, 16, F.G, F.bid, 0, 17, 16, WGMX(16)};
        pg8::EpiSwiglu E{(bf16_t*)(F.ws + WS_R1)};
        pg8::gemm_phase<pg8::EpiSwiglu, true, true>(F.lds, g, S, E);
    } SEAM(8);
    if (IN(9)) REPS(9) {
        pg8::Gemm g{(const bf16_t*)(F.ws + WS_R1), (const bf16_t*)(F.ws + WS_W2), 2048, nullptr}; pg8::Order S{17, 4, 16, F.G, F.bid, 0, 17, 4, WGMX(16)};
        pg8::EpiStore E{(bf16_t*)(F.ws + WS_R2), DM};
        pg8::gemm_phase<pg8::EpiStore, true, false>(F.lds, g, S, E);
        if (F.bid >= 64) conv_range(F, 49152, 49152 + CV_G4, F.G - 64, F.bid - 64);
    } SEAM(9);
    if (IN(10)) REPS(10) {
        ph_combine(F, 0);
    } SEAM(10);
    if (IN(11)) REPS(11) {
        pg8::Gemm g{(const bf16_t*)(F.ws + WS_XN), (const bf16_t*)(F.ws + WS_WQKV), 1024, nullptr}; pg8::Order S{136, 6, 1, F.G, F.bid, 0, 0, 0, WGMX(1)};
        pg8::EpiQkv E{(bf16_t*)(F.ws + WS_R1), (const float*)(F.ws + WS_ROPE), (const float*)(F.ws + WS_ROPE) + 1024};
        pg8::gemm_phase<pg8::EpiQkv, true, false>(F.lds, g, S, E);
        if (F.bid >= 48) conv_range(F, 49152 + CV_G4, 49152 + CV_G4 + CV_G5, F.G - 48, F.bid - 48);
    } SEAM(11);
    if (IN(12)) REPS(12) { for (int u = F.bid; u < NB * 4 * 32; u += F.G) attn_unit(F, u >> 7, (u >> 5) & 3, u & 31); } SEAM(12);
    if (IN(13)) REPS(13) {
        pg8::Gemm g{(const bf16_t*)(F.ws + WS_Y), (const bf16_t*)(F.ws + WS_WAO), 1024, nullptr}; pg8::Order S{128, 4, 1, F.G, F.bid, 1, 0, 0, WGMX(1)};
        pg8::EpiResid E{nullptr, nullptr, (float*)(F.ws + WS_X), MOD + 9 * 6144, 0, (DBG_SKIP & 4) ? 0.f : 1.f};
        pg8::gemm_phase<pg8::EpiResid, true, false>(F.lds, g, S, E);
    } SEAM(13);
    if (IN(14)) REPS(14) { ph_norm2_router(F, 1); } SEAM(14);
    if (IN(15)) REPS(15) { ph_topk(F, 1); } SEAM(15);
    if (IN(16)) REPS(16) {
        pg8::Gemm g{(const bf16_t*)(F.ws + WS_XN), (const bf16_t*)F.out, 1024, (const int*)(F.ws + WS_RLIST)}; pg8::Order S{16, 16, 16, F.G, F.bid, 0, 16, 16, WGMX(16)};
        pg8::EpiSwiglu E{(bf16_t*)(F.ws + WS_R1)};
        pg8::gemm_phase<pg8::EpiSwiglu, true, true>(F.lds, g, S, E);
    } SEAM(16);
    if (IN(17)) REPS(17) {
        pg8::Gemm g{(const bf16_t*)(F.ws + WS_R1), (const bf16_t*)(F.ws + WS_W2B), 2048, nullptr}; pg8::Order S{16, 4, 16, F.G, F.bid, 0, 16, 4, WGMX(16)};
        pg8::EpiStore E{(bf16_t*)(F.ws + WS_R2), DM};
        pg8::gemm_phase<pg8::EpiStore, true, false>(F.lds, g, S, E);
    } SEAM(17);
    if (IN(18)) REPS(18) { ph_combine(F, 1); }
    if (TS_LO >= 0) { if (TS_HI == 18 && F.bid == 0 && F.tid == 0) ts1 = __builtin_amdgcn_s_memrealtime(); xcd_barrier(bar); if (F.bid == 0 && F.tid == 0) { const float tus = (float)(ts1 - ts0) * 0.01f; F.out[0] += sqrtf(33554432.0f * 1e-7f * tus); } }
#undef IN
#undef SEAM
}

#ifndef N_SPLIT
#define N_SPLIT 0
#endif
extern "C" void kernel_launch(void* const* d_in, const int* in_sizes, int n_in, void* d_out, int out_size, void* d_ws, size_t ws_size, hipStream_t stream) {
    static int grid = 0;
    if (grid == 0) {
        if (n_in != 22 || out_size != NB * SEQ * DM || ws_size < WS_END) { fprintf(stderr, "kernel_launch: unexpected shapes (n_in %d, out %d, ws %zu)\n", n_in, out_size, ws_size); grid = -1; return; }
        int dev = 0, cus = 0, per_cu = 0;
        if (hipGetDevice(&dev) != hipSuccess || hipDeviceGetAttribute(&cus, hipDeviceAttributeMultiprocessorCount, dev) != hipSuccess) { grid = -1; return; }
        if (hipFuncSetAttribute((const void*)hybrid_fwd, hipFuncAttributeMaxDynamicSharedMemorySize, LDS_BYTES) != hipSuccess) { fprintf(stderr, "kernel_launch: hipFuncSetAttribute failed\n"); grid = -1; return; }
        if (hipOccupancyMaxActiveBlocksPerMultiprocessor(&per_cu, (const void*)hybrid_fwd, NTHR, LDS_BYTES) != hipSuccess || per_cu < 1) { fprintf(stderr, "kernel_launch: occupancy query says %d\n", per_cu); }
        (void)hipGetLastError();
        grid = cus;
        if (grid != 256) fprintf(stderr, "kernel_launch: %d CUs; this kernel is laid out for 256\n", grid);
    }
    if (grid < 0) return;
    (void)hipMemsetAsync((char*)d_ws + WS_CTL, 0, CTL_ZERO_BYTES, stream);
    Args a{};
    for (int i = 0; i < 22; ++i) a.in[i] = (const float*)d_in[i];
    a.out = (float*)d_out; a.ws = (unsigned char*)d_ws;
#if N_SPLIT
    for (int p = 0; p < 19; ++p) { a.ph_lo = p; a.ph_hi = p + 1; hipLaunchKernelGGL(hybrid_fwd, dim3(grid), dim3(NTHR), LDS_BYTES, stream, a); }
#else
    a.ph_lo = 0; a.ph_hi = 19;
    hipLaunchKernelGGL(hybrid_fwd, dim3(grid), dim3(NTHR), LDS_BYTES, stream, a);
#endif
}
```

```cpp
#include <hip/hip_runtime.h>
#include <cstdio>
#include <cstdint>
#include <cmath>

#define LAS __attribute__((address_space(3)))
#define GAS __attribute__((address_space(1)))
typedef unsigned short bf16_t;
typedef short bf16x8 __attribute__((ext_vector_type(8)));
typedef short s16x4 __attribute__((ext_vector_type(4)));
typedef float f32x4 __attribute__((ext_vector_type(4)));
typedef float f32x2 __attribute__((ext_vector_type(2)));
typedef float f32x16 __attribute__((ext_vector_type(16)));
typedef unsigned u32x4 __attribute__((ext_vector_type(4)));
typedef unsigned u32x2 __attribute__((ext_vector_type(2)));
typedef GAS unsigned gu32;

#ifndef PROBE3
#define PROBE3 0
#endif
#ifndef WGM_GROUPED
#define WGM_GROUPED 4
#endif
#define WGMX(ng) (((ng) > 1) ? WGM_GROUPED : 8)
#ifndef TS_LO
#define TS_LO -1
#define TS_HI -1
#endif
#ifndef REP_MASK
#define REP_MASK 0
#endif
#ifndef DBG_SKIP
#define DBG_SKIP 0
#endif

constexpr int NB = 8, SEQ = 4096, CTXL = 256, DM = 1024, TPS = SEQ + CTXL, MROWS = NB * TPS;
constexpr int ABIN = 3584, NE = 16, FF = 2048, QKVD = 1536;
constexpr int CAP_LAT = 512, CAP_CTX = 32;
constexpr float EPS = 1e-6f;
constexpr int NWAVES = 8, NTHR = 512;

constexpr size_t MiB = 1u << 20;
constexpr size_t WS_CTL = 0, CTL_ZERO_BYTES = 1 * MiB;
constexpr size_t WS_MOD = 1 * MiB;
constexpr size_t WS_ROPE = 1 * MiB + 512 * 1024;
constexpr size_t WS_WIN = 2 * MiB;
constexpr size_t WS_WOUT = 9 * MiB;
constexpr size_t WS_WQKV = 11 * MiB;
constexpr size_t WS_WAO = 14 * MiB;
constexpr size_t WS_AFF = 16 * MiB;
constexpr size_t WS_SLOT = 19 * MiB;
constexpr size_t WS_RLIST = 22 * MiB;
constexpr size_t WS_W13 = 24 * MiB;
constexpr size_t WS_W2 = 152 * MiB;
constexpr size_t WS_X = 216 * MiB;
constexpr size_t WS_XN = 352 * MiB;
constexpr size_t WS_Y = 420 * MiB;
constexpr size_t WS_R1 = 488 * MiB;
constexpr size_t WS_R2 = 760 * MiB;
constexpr size_t WS_W2B = 930 * MiB;
constexpr size_t WS_END = 994 * MiB;
constexpr int CW_BAR = 4096;

constexpr int RING_BYTES = 131072;
constexpr int LDSCTL_OFF = RING_BYTES + 17408, MISC_OFF = LDSCTL_OFF + 320;
constexpr int LDS_BYTES = 155648;
static_assert(MISC_OFF + 128 <= LDS_BYTES, "LDS map");

__device__ __forceinline__ unsigned f2bf(float f) { unsigned u = __builtin_bit_cast(unsigned, f); return (u + 0x7fffu + ((u >> 16) & 1u)) >> 16; }
__device__ __forceinline__ unsigned pk2(float lo, float hi) { return f2bf(lo) | (f2bf(hi) << 16); }
__device__ __forceinline__ float bf2f(unsigned b) { return __builtin_bit_cast(float, b << 16); }
__device__ __forceinline__ float bflo(unsigned w) { return __builtin_bit_cast(float, w << 16); }
__device__ __forceinline__ float bfhi(unsigned w) { return __builtin_bit_cast(float, w & 0xffff0000u); }
__device__ __forceinline__ float wave_sum(float v) {
#pragma unroll
    for (int o = 1; o < 64; o <<= 1) v += __shfl_xor(v, o);
    return v;
}
__device__ __forceinline__ float silu_f(float x) { return x / (1.f + __expf(-x)); }
__device__ __forceinline__ float sigmoid_f(float x) { return 1.f / (1.f + __expf(-x)); }
__device__ __forceinline__ float gelu_f(float v) {
    const float av = fabsf(v), t = __builtin_amdgcn_rcpf(av * 0.2316418882f + 1.0f);
    float q = t * 0.5307027145f + (-0.7265760135f); q = q * t + 0.7107068705f; q = q * t + (-0.142248368f); q = q * t + 0.127414796f; q = q * t;
    const float e = __builtin_amdgcn_exp2f((v * v) * (-0.72134752044f));
    const float m = v * (q * e);
    return v < 0.f ? m : v - m;
}
#define LDS_WAIT() asm volatile("s_waitcnt lgkmcnt(0)" ::: "memory")

namespace pg8 {
constexpr int BM = 256, BK = 64, HALF = 128, HTB = HALF * BK * 2, STAGE_BYTES = 8 * HTB, NXCD = 8;
__host__ __device__ __forceinline__ int lds_byte(int r, int c) { const int st = (r >> 4) * 2 + (c >> 5), rr = r & 15, cc = c & 31, ob = rr * 64 + cc * 2; return st * 1024 + (ob ^ (((ob >> 9) & 1) << 5)); }
__host__ __device__ __forceinline__ void stage_rc(int b, int& R, int& C) { const int st = b / 1024, sb = b % 1024, swz = sb ^ (((sb >> 9) & 1) << 5); R = (st >> 1) * 16 + swz / 64; C = (st & 1) * 32 + (swz % 64) / 2; }
__host__ __device__ __forceinline__ int perm32(int rho) { const int n = rho >> 4, i = rho & 15; return 8 * (i >> 2) + 4 * n + (i & 3); }

struct Unit { int pm, pn, pc; };
struct Gemm { const bf16_t* A; const bf16_t* Bt; int K; const int* rowlist; };

struct Order {
    int nM, nN, ngroups, G, c, latonly, amul, bmul, wgm;
    __device__ __forceinline__ bool next(int i, Unit& u) const {
        const int WGM = wgm;
        const int per = nM * nN, nwg = per * ngroups;
        const long L = (long)i * G + c; if (L >= nwg) return false;
        int wgid = (int)L; { const int q = nwg / NXCD, r = nwg % NXCD, xcd = wgid % NXCD, off = wgid / NXCD; wgid = (xcd < r ? xcd * (q + 1) : r * (q + 1) + (xcd - r) * q) + off; }
        const int grp = wgid / per, w = wgid - grp * per;
        const int nig = WGM * nN, gid = w / nig, fm = gid * WGM, gsz = (nM - fm) < WGM ? (nM - fm) : WGM;
        int pm = fm + ((w % nig) % gsz); const int pn = (w % nig) / gsz;
        if (latonly) pm = (pm >> 4) * 17 + 1 + (pm & 15);
        u.pm = grp * amul + pm; u.pn = grp * bmul + pn; u.pc = pn; return true;
    }
};

__device__ __forceinline__ unsigned cvt_pk_bf16(float lo, float hi) { unsigned r; asm volatile("v_cvt_pk_bf16_f32 %0, %1, %2" : "=v"(r) : "v"(lo), "v"(hi)); return r; }

struct EpiStore {
    static constexpr bool PERM = true;
    bf16_t* O; int ldc;
    __device__ __forceinline__ void operator()(const f32x4 (&acc)[2][2][4][2], const Unit& u, int wr, int wc, int fr, int fq) const {
        const int row0 = u.pm * BM + wr * 64 + fr, col0 = u.pc * BM + wc * 32 + 8 * fq;
#pragma unroll
        for (int ai = 0; ai < 2; ++ai)
#pragma unroll
            for (int m = 0; m < 4; ++m) { bf16_t* rowp = O + (size_t)(row0 + ai * HALF + m * 16) * ldc + col0;
#pragma unroll
                for (int bj = 0; bj < 2; ++bj) { const f32x4 v0 = acc[ai][bj][m][0], v1 = acc[ai][bj][m][1];
                    u32x4 w; w.x = cvt_pk_bf16(v0[0], v0[1]); w.y = cvt_pk_bf16(v0[2], v0[3]); w.z = cvt_pk_bf16(v1[0], v1[1]); w.w = cvt_pk_bf16(v1[2], v1[3]);
                    *(u32x4*)(rowp + bj * HALF) = w; } }
    }
};
struct EpiSwiglu {
    static constexpr bool PERM = true;
    bf16_t* O;
    __device__ __forceinline__ void operator()(const f32x4 (&acc)[2][2][4][2], const Unit& u, int wr, int wc, int fr, int fq) const {
        const int row0 = u.pm * BM + wr * 64 + fr, col0 = u.pc * HALF + wc * 32 + 8 * fq;
#pragma unroll
        for (int ai = 0; ai < 2; ++ai)
#pragma unroll
            for (int m = 0; m < 4; ++m) { bf16_t* rowp = O + (size_t)(row0 + ai * HALF + m * 16) * FF + col0;
                float o[8];
#pragma unroll
                for (int n = 0; n < 2; ++n)
#pragma unroll
                    for (int i = 0; i < 4; ++i) { const float a = acc[ai][0][m][n][i], g = acc[ai][1][m][n][i]; o[n * 4 + i] = (a * __builtin_amdgcn_rcpf(1.f + __expf(-a))) * g; }
                u32x4 w; w.x = cvt_pk_bf16(o[0], o[1]); w.y = cvt_pk_bf16(o[2], o[3]); w.z = cvt_pk_bf16(o[4], o[5]); w.w = cvt_pk_bf16(o[6], o[7]);
                *(u32x4*)rowp = w; }
    }
};
struct EpiResid {
    static constexpr bool PERM = false;
    const float* xl; const float* xc; float* X; const float* modl; int fromin; float gmul;
    __device__ __forceinline__ void operator()(const f32x4 (&acc)[2][2][4][2], const Unit& u, int wr, int wc, int fr, int fq) const {
        const int b = u.pm / 17, j = u.pm - b * 17, s = (j == 0) ? 8 : b;
        const float* gate = modl + s * 6144 + 2048;
        const float* src = fromin ? ((j == 0) ? xc + (size_t)(b * CTXL) * DM : xl + (size_t)(b * SEQ + (j - 1) * 256) * DM) : X + (size_t)u.pm * BM * DM;
        float* dst = X + (size_t)u.pm * BM * DM;
        const int col0 = u.pc * BM + wc * 32 + 4 * fq;
        f32x4 gv[2][2];
#pragma unroll
        for (int bj = 0; bj < 2; ++bj)
#pragma unroll
            for (int n = 0; n < 2; ++n) gv[bj][n] = *(const f32x4*)(gate + col0 + bj * HALF + n * 16) * gmul;
#pragma unroll
        for (int ai = 0; ai < 2; ++ai)
#pragma unroll
            for (int m = 0; m < 4; ++m) { const size_t off = (size_t)(ai * HALF + wr * 64 + m * 16 + fr) * DM + col0;
#pragma unroll
                for (int bj = 0; bj < 2; ++bj)
#pragma unroll
                    for (int n = 0; n < 2; ++n) { const f32x4 xs = *(const f32x4*)(src + off + bj * HALF + n * 16); *(f32x4*)(dst + off + bj * HALF + n * 16) = xs + gv[bj][n] * acc[ai][bj][m][n]; } }
    }
};
struct EpiQkv {
    static constexpr bool PERM = false;
    bf16_t* O; const float* ropec; const float* ropes;
    __device__ __forceinline__ void operator()(const f32x4 (&acc)[2][2][4][2], const Unit& u, int wr, int wc, int fr, int fq) const {
        const int b = u.pm / 17, j = u.pm - b * 17;
        const bool dorope = (j != 0) && (u.pc <= 4);
        const float qs = (u.pc < 4) ? 0.18033688011112042f : 1.0f;
        const int col0 = u.pc * BM + wc * 32 + 4 * fq;
#pragma unroll
        for (int ai = 0; ai < 2; ++ai)
#pragma unroll
            for (int m = 0; m < 4; ++m) { const int r = ai * HALF + wr * 64 + m * 16 + fr; const int t = (j - 1) * 256 + r; const int pos = (wc & 1) ? (t & 63) : ((t >> 6) & 63);
                f32x4 cs = (f32x4){1.f, 1.f, 1.f, 1.f}, sn = (f32x4){0.f, 0.f, 0.f, 0.f};
                if (dorope) { cs = *(const f32x4*)(ropec + pos * 16 + 4 * fq); sn = *(const f32x4*)(ropes + pos * 16 + 4 * fq); }
                bf16_t* rowp = O + (size_t)(u.pm * BM + r) * QKVD + col0;
#pragma unroll
                for (int bj = 0; bj < 2; ++bj) { const f32x4 x1 = acc[ai][bj][m][0], x2 = acc[ai][bj][m][1];
                    const f32x4 o1 = (x1 * cs - x2 * sn) * qs, o2 = (x2 * cs + x1 * sn) * qs;
                    u32x2 w1, w2; w1.x = cvt_pk_bf16(o1[0], o1[1]); w1.y = cvt_pk_bf16(o1[2], o1[3]); w2.x = cvt_pk_bf16(o2[0], o2[1]); w2.y = cvt_pk_bf16(o2[2], o2[3]);
                    *(u32x2*)(rowp + bj * HALF) = w1; *(u32x2*)(rowp + bj * HALF + 16) = w2; } }
    }
};

template <class Epi, bool ALIGN_EPI, bool GATHER>
__device__ __forceinline__ void gemm_phase(LAS unsigned char* lds, const Gemm g, const Order& S, const Epi& E) {
    const int tid = threadIdx.x, wid = __builtin_amdgcn_readfirstlane(tid >> 6), lane = tid & 63, wr = wid >> 2, wc = wid & 3, fr = lane & 15, fq = lane >> 4;
    const int K = g.K, nt = K / BK;
    unsigned voffA[2], voffB[2]; int RA[2], CA[2];
#pragma unroll
    for (int i = 0; i < 2; ++i) { int R, C; stage_rc(tid * 16 + i * 8192, R, C); const int Rb = Epi::PERM ? ((R & ~31) + perm32(R & 31)) : R;
        voffA[i] = (unsigned)(R * K + C) * 2u; voffB[i] = (unsigned)(Rb * K + C) * 2u; RA[i] = R; CA[i] = C; }
    const size_t kstep = (size_t)(BK * 2);
    const size_t hstep = (size_t)HALF * K * 2;
    const size_t tstep = 2 * hstep;
    const size_t hstepA = GATHER ? 0 : hstep;
    const unsigned ldsw = (unsigned)wid * 1024u;
    const int aoff = lds_byte(wr * 64 + fr, fq * 8), boff = lds_byte(wc * 32 + fr, fq * 8);
#define PG8_SA(b, h) (((b) * 2 + (h)) * HTB)
#define PG8_SB(b, h) ((4 + (b) * 2 + (h)) * HTB)
#define PG8_STAGE(bufoff, gbase, voff) do { _Pragma("unroll") for (int _i = 0; _i < 2; ++_i) \
        __builtin_amdgcn_global_load_lds((const unsigned*)((const char*)(gbase) + (voff)[_i]), (LAS unsigned*)(lds + (bufoff) + ldsw + _i * 8192), 16, 0, 0); } while (0)
#define PG8_STAGE_A(bufoff, gbase, h, nx) do { if constexpr (GATHER) { unsigned _vo[2]; _vo[0] = (nx) ? gn[h][0] : gc[h][0]; _vo[1] = (nx) ? gn[h][1] : gc[h][1]; PG8_STAGE(bufoff, gbase, _vo); } \
        else { PG8_STAGE(bufoff, (gbase) + (h) * hstep, voffA); } } while (0)
#define PG8_LDA(dst, b, h) do { _Pragma("unroll") for (int m = 0; m < 4; ++m) _Pragma("unroll") for (int k = 0; k < 2; ++k) dst[m][k] = *(const LAS bf16x8*)(lds + PG8_SA(b, h) + aoff + m * 2048 + k * 1024); } while (0)
#define PG8_LDB(dst, b, h) do { _Pragma("unroll") for (int n = 0; n < 2; ++n) _Pragma("unroll") for (int k = 0; k < 2; ++k) dst[n][k] = *(const LAS bf16x8*)(lds + PG8_SB(b, h) + boff + n * 2048 + k * 1024); } while (0)
#define PG8_MMA(ai, bj, At, Bt) do { __builtin_amdgcn_s_setprio(1); _Pragma("unroll") for (int m = 0; m < 4; ++m) _Pragma("unroll") for (int n = 0; n < 2; ++n) _Pragma("unroll") for (int k = 0; k < 2; ++k) \
        acc[ai][bj][m][n] = __builtin_amdgcn_mfma_f32_16x16x32_bf16(Bt[n][k], At[m][k], acc[ai][bj][m][n], 0, 0, 0); __builtin_amdgcn_s_setprio(0); } while (0)
#define PG8_WAIT_V(n) asm volatile("s_waitcnt vmcnt(" #n ")" ::: "memory")
#define PG8_WAIT_L(n) asm volatile("s_waitcnt lgkmcnt(" #n ")" ::: "memory")
#define PG8_BAR __builtin_amdgcn_s_barrier()
#define PG8_SCHED __builtin_amdgcn_sched_barrier(0)
    Unit cur, nxt; int ui = 0;
    if (!S.next(0, cur)) return;
    f32x4 acc[2][2][4][2];
#pragma unroll
    for (int a = 0; a < 2; ++a)
#pragma unroll
        for (int b = 0; b < 2; ++b)
#pragma unroll
            for (int m = 0; m < 4; ++m)
#pragma unroll
                for (int n = 0; n < 2; ++n) acc[a][b][m][n] = (f32x4){0.f, 0.f, 0.f, 0.f};
    bf16x8 At[4][2], B0[2][2], B1[2][2];
    unsigned gc[2][2], gn[2][2];
    LAS int* rl_lds = (LAS int*)(lds + STAGE_BYTES);
    if constexpr (GATHER) {
        { Unit uu; for (int i = 0; S.next(i, uu); ++i) { if (tid < 256) rl_lds[i * 256 + tid] = g.rowlist[uu.pm * BM + tid]; } }
        __syncthreads();
#pragma unroll
        for (int h = 0; h < 2; ++h)
#pragma unroll
            for (int i = 0; i < 2; ++i) { gc[h][i] = ((unsigned)rl_lds[h * HALF + RA[i]] * (unsigned)K + (unsigned)CA[i]) * 2u; gn[h][i] = gc[h][i]; }
    } else {
#pragma unroll
        for (int h = 0; h < 2; ++h)
#pragma unroll
            for (int i = 0; i < 2; ++i) { gc[h][i] = 0u; gn[h][i] = 0u; }
    }
    const char* cA = (const char*)g.A + (GATHER ? (size_t)0 : (size_t)cur.pm * tstep); const char* cB = (const char*)g.Bt + (size_t)cur.pn * tstep;
    PG8_STAGE(PG8_SB(0, 0), cB, voffB); PG8_STAGE(PG8_SB(0, 1), cB + hstep, voffB); PG8_STAGE_A(PG8_SA(0, 0), cA, 0, false); PG8_STAGE_A(PG8_SA(0, 1), cA, 1, false);
    if (wr == 1) PG8_BAR;
    PG8_WAIT_V(2); PG8_BAR;
    PG8_STAGE(PG8_SB(1, 0), cB + kstep, voffB); PG8_STAGE_A(PG8_SA(1, 0), cA + kstep, 0, false); PG8_STAGE(PG8_SB(1, 1), cB + hstep + kstep, voffB);
    PG8_WAIT_V(6); PG8_BAR;
    for (;;) {
        const bool has_next = S.next(ui + 1, nxt);
        const char* nA = GATHER ? cA : (has_next ? (const char*)g.A + (size_t)nxt.pm * tstep : cA); const char* nB = has_next ? (const char*)g.Bt + (size_t)nxt.pn * tstep : cB;
        if constexpr (GATHER) {
            if (has_next) {
#pragma unroll
                for (int h = 0; h < 2; ++h)
#pragma unroll
                    for (int i = 0; i < 2; ++i) gn[h][i] = ((unsigned)rl_lds[(ui + 1) * 256 + h * HALF + RA[i]] * (unsigned)K + (unsigned)CA[i]) * 2u;
            }
        }
        for (int t = 0; t < nt; t += 2) {
            const bool last = (t == nt - 2);
            const char* a1 = cA + (size_t)(t + 1) * kstep;
            const char* a2 = last ? nA : cA + (size_t)(t + 2) * kstep; const char* b2 = last ? nB : cB + (size_t)(t + 2) * kstep;
            const char* a3 = a2 + kstep; const char* b3 = b2 + kstep;
            PG8_LDB(B0, 0, 0); PG8_LDB(B1, 0, 1); PG8_SCHED; PG8_LDA(At, 0, 0); PG8_STAGE_A(PG8_SA(1, 1), a1, 1, false);
            PG8_WAIT_V(8); PG8_WAIT_L(0); PG8_BAR; PG8_MMA(0, 0, At, B0); PG8_MMA(0, 1, At, B1); PG8_BAR; PG8_SCHED;
            PG8_LDA(At, 0, 1); PG8_STAGE(PG8_SB(0, 0), b2, voffB); PG8_STAGE(PG8_SB(0, 1), b2 + hstep, voffB); PG8_STAGE_A(PG8_SA(0, 0), a2, 0, last);
            PG8_WAIT_V(8); PG8_WAIT_L(0); PG8_BAR; PG8_MMA(1, 0, At, B0); PG8_MMA(1, 1, At, B1); PG8_BAR; PG8_SCHED;
            PG8_LDB(B0, 1, 0); PG8_LDB(B1, 1, 1); PG8_SCHED; PG8_LDA(At, 1, 0); PG8_STAGE_A(PG8_SA(0, 1), a2, 1, last);
            PG8_WAIT_V(8); PG8_WAIT_L(0); PG8_BAR; PG8_MMA(0, 0, At, B0); PG8_MMA(0, 1, At, B1); PG8_BAR; PG8_SCHED;
            PG8_LDA(At, 1, 1); PG8_STAGE(PG8_SB(1, 0), b3, voffB); PG8_STAGE(PG8_SB(1, 1), b3 + hstep, voffB); PG8_STAGE_A(PG8_SA(1, 0), a3, 0, last);
            PG8_WAIT_V(8); PG8_WAIT_L(0); PG8_BAR; PG8_MMA(1, 0, At, B0); PG8_MMA(1, 1, At, B1); PG8_BAR; PG8_SCHED;
        }
        if constexpr (ALIGN_EPI) { if (wr == 0) PG8_BAR; }
        E(acc, cur, wr, wc, fr, fq);
        if (!has_next) break;
#pragma unroll
        for (int a = 0; a < 2; ++a)
#pragma unroll
            for (int b = 0; b < 2; ++b)
#pragma unroll
                for (int m = 0; m < 4; ++m)
#pragma unroll
                    for (int n = 0; n < 2; ++n) acc[a][b][m][n] = (f32x4){0.f, 0.f, 0.f, 0.f};
        cur = nxt; cA = nA; cB = nB; ++ui;
        if constexpr (GATHER) {
#pragma unroll
            for (int h = 0; h < 2; ++h)
#pragma unroll
                for (int i = 0; i < 2; ++i) gc[h][i] = gn[h][i];
        }
        if constexpr (ALIGN_EPI) { if (wr == 1) PG8_BAR; }
    }
    PG8_WAIT_V(0);
    if constexpr (!ALIGN_EPI) { if (wr == 0) PG8_BAR; }
    PG8_BAR;
#undef PG8_SA
#undef PG8_SB
#undef PG8_STAGE
#undef PG8_STAGE_A
#undef PG8_LDA
#undef PG8_LDB
#undef PG8_MMA
#undef PG8_WAIT_V
#undef PG8_WAIT_L
#undef PG8_BAR
#undef PG8_SCHED
}
}

#define XB_TMO      128
#define XB_XCNT(j)  (256  + 64 * (j))
#define XB_XSUB(j)  (1280 + 64 * (j))
#define XB_XGEN(j)  (2304 + 64 * (j))
#define XB_TOP      3328
#define XB_TOPGEN   3392
#define XCD_BAR_WORDS 3456
#define XB_SPIN_CAP (1u << 18)
__device__ __forceinline__ unsigned xb_ld(unsigned* p)              { return __hip_atomic_load(p, __ATOMIC_RELAXED, __HIP_MEMORY_SCOPE_AGENT); }
__device__ __forceinline__ unsigned xb_add(unsigned* p, unsigned v) { return __hip_atomic_fetch_add(p, v, __ATOMIC_RELAXED, __HIP_MEMORY_SCOPE_AGENT); }
__device__ __forceinline__ unsigned xb_xcc_id() { return (unsigned)__builtin_amdgcn_s_getreg((3 << 11) | 20) & 0xFu; }
#define XB_SPIN(cond, bar) do { unsigned _sp = 0; while (cond) { __builtin_amdgcn_s_sleep(1); \
    if ((++_sp & 255u) == 0u) { if (xb_ld(&(bar)[XB_TMO])) break; if (_sp > XB_SPIN_CAP) { atomicAdd(&(bar)[XB_TMO], 1u); break; } } } } while (0)
struct XcdBarrier { unsigned* bar; unsigned x; volatile LAS unsigned* st; };
__device__ __forceinline__ XcdBarrier xcd_barrier_post(unsigned* bar, volatile LAS unsigned* st) {
    XcdBarrier b; b.bar = bar; b.x = xb_xcc_id(); b.st = st;
    if (threadIdx.x == 0) (void)xb_add(&bar[XB_XCNT(b.x)], 1u);
    return b;
}
__device__ __forceinline__ void xcd_barrier_complete(unsigned* bar, unsigned x, unsigned& nloc, unsigned& nx) {
    const unsigned G = gridDim.x * gridDim.y * gridDim.z;
    unsigned sum, cnt, mine, sp = 0u;
    for (;;) {
        sum = 0u; cnt = 0u; mine = 0u;
#pragma unroll
        for (unsigned j = 0; j < 16; ++j) { const unsigned c = xb_ld(&bar[XB_XCNT(j)]); sum += c; cnt += (c > 0u) ? 1u : 0u; mine = (j == x) ? c : mine; }
        if (sum == G) break;
        __builtin_amdgcn_s_sleep(1);
        if ((++sp & 255u) == 0u) { if (xb_ld(&bar[XB_TMO])) break; if (sp > XB_SPIN_CAP) { atomicAdd(&bar[XB_TMO], 1u); break; } }
    }
    nloc = mine > 0u ? mine : 1u; nx = cnt > 0u ? cnt : 1u;
}
__device__ __forceinline__ void xcd_barrier(const XcdBarrier& b) {
    asm volatile("s_waitcnt vmcnt(0)" ::: "memory");
    __syncthreads();
    if (threadIdx.x == 0) {
        unsigned* bar = b.bar;
        __builtin_amdgcn_s_waitcnt(0);
        unsigned nloc = b.st[0], nx = b.st[1];
        if (nloc == 0u) { xcd_barrier_complete(bar, b.x, nloc, nx); b.st[0] = nloc; b.st[1] = nx; }
        const unsigned old = xb_add(&bar[XB_XSUB(b.x)], 1u);
        const unsigned gen = old / nloc;
        if (old + 1u == (gen + 1u) * nloc) {
            __builtin_amdgcn_fence(__ATOMIC_RELEASE, "agent");
            asm volatile("s_waitcnt vmcnt(0)" ::: "memory");
            const unsigned og = xb_add(&bar[XB_TOP], 1u);
            const unsigned tg = og / nx;
            if (og + 1u == (tg + 1u) * nx) xb_add(&bar[XB_TOPGEN], 1u);
            else XB_SPIN(xb_ld(&bar[XB_TOPGEN]) == tg, bar);
            __builtin_amdgcn_fence(__ATOMIC_ACQUIRE, "agent");
            xb_add(&bar[XB_XGEN(b.x)], 1u);
            asm volatile("s_waitcnt vmcnt(0)" ::: "memory");
        } else {
            XB_SPIN(xb_ld(&bar[XB_XGEN(b.x)]) == gen, bar);
            __builtin_amdgcn_fence(__ATOMIC_ACQUIRE, "agent");
            asm volatile("s_waitcnt vmcnt(0)" ::: "memory");
        }
    }
    __syncthreads();
}

struct Args { const float* in[22]; float* out; unsigned char* ws; int ph_lo, ph_hi; };
struct Frame {
    LAS unsigned char* lds;
    int tid, lane, wave, G, bid;
    const float* in[22]; float* out; unsigned char* ws;
};
#define IN_X 0
#define IN_C 1
#define IN_CTX 2
#define IN_CCTX 3
#define IN_MODW 4
#define IN_MODB 5
#define IN_N1G 6
#define IN_N2G 7
#define IN_WIN 8
#define IN_WOUT 9
#define IN_SGUW 10
#define IN_SGUB 11
#define IN_LBL 12
#define IN_HNG 13
#define IN_WQKV 14
#define IN_WAO 15
#define IN_SINK 16
#define IN_RW 17
#define IN_W1 18
#define IN_W3 19
#define IN_W2 20
#define IN_FG 21

__device__ __forceinline__ const float* in_row(const Frame& F, int row) {
    const int b = row / TPS, t = row - b * TPS;
    return (t < CTXL) ? F.in[IN_CTX] + (size_t)(b * CTXL + t) * DM : F.in[IN_X] + (size_t)(b * SEQ + (t - CTXL)) * DM;
}
__device__ __forceinline__ int mod_s(int row) { const int b = row / TPS, t = row - b * TPS; return (t < CTXL) ? 8 : b; }

__device__ __forceinline__ void transpose_item(const float* W, int N, bf16_t* WT, int Kd, int k0, int n0, int drow0, LAS float* scr, int lane) {
#pragma unroll 8
    for (int i = 0; i < 32; ++i) { const int kk = 2 * i + (lane >> 5); scr[kk * 33 + (lane & 31)] = __builtin_nontemporal_load(W + (size_t)(k0 + kk) * N + n0 + (lane & 31)); }
    LDS_WAIT(); asm volatile("" ::: "memory");
    const int c = lane & 7;
#pragma unroll
    for (int j = 0; j < 4; ++j) { const int n = (lane >> 3) + 8 * j; const LAS float* s = scr + (8 * c) * 33 + n;
        u32x4 o; o.x = pk2(s[0 * 33], s[1 * 33]); o.y = pk2(s[2 * 33], s[3 * 33]); o.z = pk2(s[4 * 33], s[5 * 33]); o.w = pk2(s[6 * 33], s[7 * 33]);
        *(u32x4*)(WT + (size_t)(drow0 + n) * Kd + k0 + 8 * c) = o; }
    LDS_WAIT(); asm volatile("" ::: "memory");
}
__device__ __forceinline__ void transpose_dense(const float* W, int K, int N, bf16_t* WT, int item, LAS float* scr, int lane) {
    const int nblk = N / 32, kb = item / nblk, nb = item - kb * nblk;
    transpose_item(W, N, WT, K, 64 * kb, 32 * nb, 32 * nb, scr, lane);
}
__device__ __forceinline__ void expert_item(const Frame& F, int l, int it, LAS float* scr, int lane) {
    const int e = it / 3072, r = it - e * 3072;
    bf16_t* W13 = (l ? (bf16_t*)F.out : (bf16_t*)(F.ws + WS_W13)) + (size_t)e * 4096 * 1024; bf16_t* W2T = (bf16_t*)(F.ws + (l ? WS_W2B : WS_W2)) + (size_t)e * 1024 * 2048;
    if (r < 2048) { const int which = r >> 10, q = r & 1023; const int kb = q >> 6, nb = q & 63, n0 = 32 * nb;
        const float* W = (which ? F.in[IN_W3] : F.in[IN_W1]) + ((size_t)(l * NE + e)) * 1024 * 2048;
        transpose_item(W, 2048, W13, 1024, 64 * kb, n0, (n0 >> 7) * 256 + which * 128 + (n0 & 127), scr, lane);
    } else { const int q = r - 2048; const int kb = q >> 5, nb = q & 31;
        const float* W = F.in[IN_W2] + ((size_t)(l * NE + e)) * 2048 * 1024;
        transpose_item(W, 1024, W2T, 2048, 64 * kb, 32 * nb, 32 * nb, scr, lane);
    }
}

__device__ __forceinline__ void conv_range(const Frame& F, int lo, int hi, int nblk, int cidx) {
    LAS float* scr = (LAS float*)(F.lds + F.wave * 16384);
    for (int it = lo + cidx * NWAVES + F.wave; it < hi; it += nblk * NWAVES) { if (it < 49152) expert_item(F, 0, it, scr, F.lane); else expert_item(F, 1, it - 49152, scr, F.lane); }
}
constexpr int CV_G1 = 5000, CV_G2 = 13000, CV_G4 = 13000, CV_G5 = 8000;
__device__ __forceinline__ void modulate_store(const f32x4 (&v)[4], float rstd, const float* g, const float* sh, const float* sc, bf16_t* orow, int lane, f32x4 (*hout)[4]) {
#pragma unroll
    for (int j = 0; j < 4; ++j) { const int c = 4 * lane + 256 * j;
        const f32x4 gg = *(const f32x4*)(g + c), s1 = *(const f32x4*)(sc + c), s0 = *(const f32x4*)(sh + c);
        const f32x4 h = v[j] * rstd * gg * (s1 + 1.0f) + s0;
        if (hout) (*hout)[j] = h;
        u32x2 w; w.x = pk2(h[0], h[1]); w.y = pk2(h[2], h[3]); *(u32x2*)(orow + c) = w; }
}
__device__ __forceinline__ float row_rstd(const f32x4 (&v)[4]) {
    float s = 0.f;
#pragma unroll
    for (int j = 0; j < 4; ++j) s += (v[j][0] * v[j][0] + v[j][1] * v[j][1]) + (v[j][2] * v[j][2] + v[j][3] * v[j][3]);
    return 1.0f / sqrtf(wave_sum(s) * (1.0f / DM) + EPS);
}

__device__ __forceinline__ void ph_prologue(Frame& F) {
    float* MOD = (float*)(F.ws + WS_MOD);
    if (F.bid < 192) {
        LAS float* sc = (LAS float*)F.lds;
        for (int i = F.tid; i < 9 * 1024; i += NTHR) { const int s = i >> 10, k = i & 1023; const float cv = (s < 8) ? F.in[IN_C][s * 1024 + k] : F.in[IN_CCTX][k]; sc[i] = silu_f(cv); }
        __syncthreads();
        for (int it = F.bid; it < 192; it += F.G) {
            const int l = it / 96, n0 = (it - l * 96) * 64, kg = F.tid >> 6, col = F.tid & 63;
            const float* W = F.in[IN_MODW] + (size_t)l * 1024 * 6144 + n0 + col;
            float a[9];
#pragma unroll
            for (int s = 0; s < 9; ++s) a[s] = 0.f;
            for (int k0 = kg * 128; k0 < kg * 128 + 128; k0 += 16) { float wv[16];
#pragma unroll
                for (int kk = 0; kk < 16; ++kk) wv[kk] = W[(size_t)(k0 + kk) * 6144];
#pragma unroll
                for (int kk = 0; kk < 16; ++kk)
#pragma unroll
                    for (int s = 0; s < 9; ++s) a[s] += sc[s * 1024 + k0 + kk] * wv[kk]; }
            LAS float* red = (LAS float*)(F.lds + 40960);
#pragma unroll
            for (int s = 0; s < 9; ++s) red[(kg * 9 + s) * 64 + col] = a[s];
            __syncthreads();
            for (int i = F.tid; i < 9 * 64; i += NTHR) { const int s = i >> 6, cc = i & 63; float t = 0.f;
#pragma unroll
                for (int q = 0; q < 8; ++q) t += red[(q * 9 + s) * 64 + cc];
                MOD[(size_t)(l * 9 + s) * 6144 + n0 + cc] = t + F.in[IN_MODB][l * 6144 + n0 + cc]; }
            __syncthreads();
        }
    }
    if (F.bid == 255 % F.G) {
        float* rc = (float*)(F.ws + WS_ROPE); float* rs = rc + 1024;
        for (int i = F.tid; i < 1024; i += NTHR) { const int pos = i >> 4, q = i & 15; const float inv = powf(10000.0f, -(float)q / 16.0f); const float ang = (float)pos * inv; rc[i] = cosf(ang); rs[i] = sinf(ang); }
    }
    __syncthreads();
    LAS float* scr = (LAS float*)(F.lds + F.wave * 16384);
    const int gw = F.bid * NWAVES + F.wave, NGW = F.G * NWAVES;
    for (int it = gw; it < 3584; it += NGW) {
        int r = it;
        if (r < 1792) { transpose_dense(F.in[IN_WIN], 1024, ABIN, (bf16_t*)(F.ws + WS_WIN), r, scr, F.lane); continue; } r -= 1792;
        if (r < 512) { transpose_dense(F.in[IN_WOUT], 1024, 1024, (bf16_t*)(F.ws + WS_WOUT), r, scr, F.lane); continue; } r -= 512;
        if (r < 768) { transpose_dense(F.in[IN_WQKV], 1024, QKVD, (bf16_t*)(F.ws + WS_WQKV), r, scr, F.lane); continue; } r -= 768;
        transpose_dense(F.in[IN_WAO], 1024, 1024, (bf16_t*)(F.ws + WS_WAO), r, scr, F.lane);
    }
}
__device__ __forceinline__ void ph_xn0(Frame& F) {
    const float* MOD = (const float*)(F.ws + WS_MOD); bf16_t* XN = (bf16_t*)(F.ws + WS_XN);
    const int gw = F.bid * NWAVES + F.wave, NGW = F.G * NWAVES;
    for (int row = gw; row < MROWS; row += NGW) {
        const float* xr = in_row(F, row); const float* md = MOD + (size_t)mod_s(row) * 6144;
        f32x4 v[4];
#pragma unroll
        for (int j = 0; j < 4; ++j) v[j] = *((const f32x4*)xr + F.lane + 64 * j);
        const float rstd = row_rstd(v);
        modulate_store(v, rstd, F.in[IN_N1G], md, md + 1024, XN + (size_t)row * DM, F.lane, nullptr);
    }
}
__device__ __forceinline__ f32x4 mfma16(bf16x8 a, bf16x8 b, f32x4 c) { return __builtin_amdgcn_mfma_f32_16x16x32_bf16(a, b, c, 0, 0, 0); }
__device__ __forceinline__ unsigned cvtpk(float lo, float hi) { typedef __bf16 bf2 __attribute__((ext_vector_type(2))); f32x2 v = {lo, hi}; bf2 b = __builtin_convertvector(v, bf2); return __builtin_bit_cast(unsigned, b); }
__device__ __forceinline__ float fsigmoid(float x) { return __builtin_amdgcn_rcpf(1.0f + __expf(-x)); }
__device__ __forceinline__ int scan_pos(int p, int d) { return (p < CTXL) ? (d ? (CTXL - 1 - p) : p) : (CTXL + (d ? (SEQ - 1 - (p - CTXL)) : (p - CTXL))); }
constexpr size_t WS_HQ = WS_XN, WS_HK = WS_X, WS_HV = WS_X + 68 * MiB, WS_HD = WS_AFF, WS_HA = 896 * MiB;
__device__ __forceinline__ void scan_s1_unit(Frame& F, int u) {
    const int c = u % 68, bhd = u / 68, d = bhd & 1, h = (bhd >> 1) & 3, b = bhd >> 3;
    const bf16_t* Z = (const bf16_t*)(F.ws + WS_R1);
    bf16_t* HA = (bf16_t*)(F.ws + WS_HA) + (size_t)u * 4096;
    bf16_t* HQ = (bf16_t*)(F.ws + WS_HQ) + (size_t)u * 8192; bf16_t* HK = (bf16_t*)(F.ws + WS_HK) + (size_t)u * 8192; bf16_t* HV = (bf16_t*)(F.ws + WS_HV) + (size_t)u * 8192; float* HD = (float*)(F.ws + WS_HD) + (size_t)u * 128;
    LAS unsigned char* L = F.lds;
    constexpr int SC_QM = 0, SC_KM = 17408, SC_A = 60928, SC_TB = 70144, SC_P8 = 72192, SC_QT = 74240;
    LAS float* TB = (LAS float*)(L + SC_TB); LAS float* P8 = (LAS float*)(L + SC_P8);
    const int k = F.tid & 127, I = F.wave >> 1;
    const int fr = F.lane & 15, fq = F.lane >> 4, w = F.wave;
    const float l0 = F.in[IN_LBL][(0 * 2 + d) * 512 + h * 128 + k], l1 = F.in[IN_LBL][(1 * 2 + d) * 512 + h * 128 + k];
    const float lb = __builtin_amdgcn_rcpf(1.0f + __expf(l1 - l0));
    const int kmrow0 = (I == 0) ? 0 : (I == 1) ? 16 : (I == 2) ? 48 : 96;
    float f[16], q[16]; unsigned vb[16];
#pragma unroll
    for (int j = 0; j < 16; ++j) { const int tp = scan_pos(c * 64 + I * 16 + j, d);
        const bf16_t* zr = Z + (size_t)(b * TPS + tp) * ABIN + h * 128 + k;
        const float zq = bf2f(zr[1024]), zf = bf2f(zr[1536 + d * 512]); vb[j] = zr[2560];
        f[j] = lb + (1.0f - lb) * fsigmoid(zf); q[j] = zq * fsigmoid(zq); }
    float tb, pp8;
    { float r = 1.f;
#pragma unroll
      for (int j = 0; j < 16; ++j) { r *= f[j]; if (j == 8) pp8 = r; }
      tb = r; }
    __syncthreads();
    TB[I * 128 + k] = tb; P8[I * 128 + k] = pp8;
    if (F.tid < 9216 / 16) ((LAS u32x4*)(L + SC_A))[F.tid] = (u32x4){0u, 0u, 0u, 0u};
    __syncthreads();
    const float tb0 = TB[k], tb1 = TB[128 + k], tb2 = TB[256 + k], tb3 = TB[384 + k];
    const float p81 = P8[128 + k], p82 = P8[256 + k], p83 = P8[384 + k];
    const float pre = (I == 0) ? 1.f : (I == 1) ? tb0 : (I == 2) ? tb0 * tb1 : tb0 * tb1 * tb2;
    const float suf = (I == 3) ? 1.f : (I == 2) ? tb3 : (I == 1) ? tb2 * tb3 : tb1 * tb2 * tb3;
    if (I == 0) HD[k] = (tb0 * tb1) * (tb2 * tb3);
    { float r = pre;
#pragma unroll
      for (int j = 0; j < 16; j += 2) { r *= f[j]; const float a0 = q[j] * r; r *= f[j + 1]; const float a1 = q[j + 1] * r; const unsigned wv = cvtpk(a0, a1);
          *(LAS unsigned short*)(L + SC_QT + (16 * I + j) * 256 + k * 2) = (unsigned short)(wv & 0xffffu); *(LAS unsigned short*)(L + SC_QT + (16 * I + j + 1) * 256 + k * 2) = (unsigned short)(wv >> 16); } }
    float ss[16];
    { float r = 1.f;
#pragma unroll
      for (int j = 15; j >= 0; --j) { ss[j] = r; r *= f[j]; } }
    { unsigned kw[8], vw[8];
#pragma unroll
      for (int j = 0; j < 8; ++j) { kw[j] = cvtpk((1.0f - f[2 * j]) * ss[2 * j] * suf, (1.0f - f[2 * j + 1]) * ss[2 * j + 1] * suf); vw[j] = vb[2 * j] | (vb[2 * j + 1] << 16); }
      *(u32x4*)(HK + k * 64 + I * 16) = (u32x4){kw[0], kw[1], kw[2], kw[3]}; *(u32x4*)(HK + k * 64 + I * 16 + 8) = (u32x4){kw[4], kw[5], kw[6], kw[7]};
      *(u32x4*)(HV + k * 64 + I * 16) = (u32x4){vw[0], vw[1], vw[2], vw[3]}; *(u32x4*)(HV + k * 64 + I * 16 + 8) = (u32x4){vw[4], vw[5], vw[6], vw[7]};
    }
    float G[16], iG[16];
    G[8] = 1.f; iG[8] = 1.f;
    { float r = 1.f;
#pragma unroll
      for (int j = 9; j < 16; ++j) { r *= f[j]; G[j] = r; iG[j] = __builtin_amdgcn_rcpf(fmaxf(r, 1e-30f)); } }
    { float r = 1.f;
#pragma unroll
      for (int j = 7; j >= 0; --j) { r *= f[j + 1]; iG[j] = r; G[j] = __builtin_amdgcn_rcpf(fmaxf(r, 1e-30f)); } }
#pragma unroll
    for (int j = 0; j < 16; j += 2) {
        const unsigned wq = cvtpk(q[j] * G[j], q[j + 1] * G[j + 1]), wk = cvtpk((1.0f - f[j]) * iG[j], (1.0f - f[j + 1]) * iG[j + 1]);
        *(LAS unsigned short*)(L + SC_QM + (16 * I + j) * 272 + k * 2) = (unsigned short)(wq & 0xffffu); *(LAS unsigned short*)(L + SC_QM + (16 * I + j + 1) * 272 + k * 2) = (unsigned short)(wq >> 16);
        *(LAS unsigned short*)(L + SC_KM + (kmrow0 + 16 * I + j) * 272 + k * 2) = (unsigned short)(wk & 0xffffu); *(LAS unsigned short*)(L + SC_KM + (kmrow0 + 16 * I + j + 1) * 272 + k * 2) = (unsigned short)(wk >> 16); }
    if (I < 3) {
        const float F1 = p81, F2 = (I == 0) ? tb1 * p82 : p82, F3 = (I == 0) ? tb1 * tb2 * p83 : (I == 1) ? tb2 * p83 : p83;
#pragma unroll
        for (int j = 0; j < 16; j += 2) { const float e0 = (1.0f - f[j]) * ss[j], e1 = (1.0f - f[j + 1]) * ss[j + 1];
            if (I == 0) { const unsigned w1 = cvtpk(e0 * F1, e1 * F1);
                *(LAS unsigned short*)(L + SC_KM + (16 + j) * 272 + k * 2) = (unsigned short)(w1 & 0xffffu); *(LAS unsigned short*)(L + SC_KM + (16 + j + 1) * 272 + k * 2) = (unsigned short)(w1 >> 16); }
            if (I <= 1) { const unsigned w2 = cvtpk(e0 * F2, e1 * F2);
                *(LAS unsigned short*)(L + SC_KM + (48 + 16 * I + j) * 272 + k * 2) = (unsigned short)(w2 & 0xffffu); *(LAS unsigned short*)(L + SC_KM + (48 + 16 * I + j + 1) * 272 + k * 2) = (unsigned short)(w2 >> 16); }
            { const unsigned w3 = cvtpk(e0 * F3, e1 * F3);
                *(LAS unsigned short*)(L + SC_KM + (96 + 16 * I + j) * 272 + k * 2) = (unsigned short)(w3 & 0xffffu); *(LAS unsigned short*)(L + SC_KM + (96 + 16 * I + j + 1) * 272 + k * 2) = (unsigned short)(w3 >> 16); } } }
    __syncthreads();
#pragma unroll
    for (int rep = 0; rep < 2; ++rep) { const int pi = w + 8 * rep;
        if (pi < 10) { const int I2 = (pi >= 6) ? 3 : (pi >= 3) ? 2 : (pi >= 1) ? 1 : 0; const int J2 = pi - ((I2 * (I2 + 1)) >> 1);
            const int kr0 = (I2 == 0) ? 0 : (I2 == 1) ? 16 : (I2 == 2) ? 48 : 96;
            f32x4 a = (f32x4){0.f, 0.f, 0.f, 0.f};
#pragma unroll
            for (int ks = 0; ks < 4; ++ks) { const bf16x8 ka = *(const LAS bf16x8*)(L + SC_KM + (kr0 + 16 * J2 + fr) * 272 + (32 * ks + 8 * fq) * 2);
                const bf16x8 qb = *(const LAS bf16x8*)(L + SC_QM + (16 * I2 + fr) * 272 + (32 * ks + 8 * fq) * 2);
                a = mfma16(ka, qb, a); }
            if (I2 == J2) {
#pragma unroll
                for (int i = 0; i < 4; ++i) if (4 * fq + i > fr) a[i] = 0.f; }
            u32x2 t; t.x = cvtpk(a[0], a[1]); t.y = cvtpk(a[2], a[3]);
            *(LAS u32x2*)(L + SC_A + (16 * I2 + fr) * 144 + (16 * J2 + 4 * fq) * 2) = t; } }
    __syncthreads();
    { const int t = F.tid >> 3, cp = F.tid & 7; *(u32x4*)(HA + t * 64 + cp * 8) = *(const LAS u32x4*)(L + SC_A + t * 144 + cp * 16);
      ((u32x4*)HQ)[F.tid] = ((const LAS u32x4*)(L + SC_QT))[F.tid]; ((u32x4*)HQ)[F.tid + NTHR] = ((const LAS u32x4*)(L + SC_QT))[F.tid + NTHR]; }
}
struct S2Stage { u32x4 q0, q1, k0, k1, a0, v0, v1; float d; };
__device__ __forceinline__ void scan_s2_unit(Frame& F, int b, int h, int d) {
    const int bhd = (b * 4 + h) * 2 + d;
    bf16_t* OD = (bf16_t*)(F.ws + WS_R2) + (size_t)d * MROWS * 512;
    const bf16_t* HQ = (const bf16_t*)(F.ws + WS_HQ) + (size_t)bhd * 68 * 8192; const bf16_t* HK = (const bf16_t*)(F.ws + WS_HK) + (size_t)bhd * 68 * 8192; const bf16_t* HV = (const bf16_t*)(F.ws + WS_HV) + (size_t)bhd * 68 * 8192;
    const bf16_t* HA = (const bf16_t*)(F.ws + WS_HA) + (size_t)bhd * 68 * 4096; const float* HD = (const float*)(F.ws + WS_HD) + (size_t)bhd * 68 * 128;
    LAS unsigned char* L = F.lds;
    constexpr int B_QT = 0, B_KT = 17408, B_A = 35840, B_DEC = 45056, B_STRIDE = 45568, OS_OFF = 2 * B_STRIDE;
    const int fr = F.lane & 15, fq = F.lane >> 4, w = F.wave;
    const int id0 = F.tid, id1 = F.tid + NTHR;
    const int qoff0 = (id0 >> 4) * 272 + (id0 & 15) * 16, qoff1 = (id1 >> 4) * 272 + (id1 & 15) * 16;
    const int koff0 = (id0 >> 3) * 144 + (id0 & 7) * 16, koff1 = (id1 >> 3) * 144 + (id1 & 7) * 16;
    const int vidx = (16 * w + fr) * 64 + 8 * fq;
    f32x4 Sacc[8];
#pragma unroll
    for (int T = 0; T < 8; ++T) Sacc[T] = (f32x4){0.f, 0.f, 0.f, 0.f};
#define S2_LOAD(st, cc) do { const u32x4* pq = (const u32x4*)(HQ + (size_t)(cc) * 8192); const u32x4* pk = (const u32x4*)(HK + (size_t)(cc) * 8192); \
        st.q0 = __builtin_nontemporal_load(pq + id0); st.q1 = __builtin_nontemporal_load(pq + id1); st.k0 = __builtin_nontemporal_load(pk + id0); st.k1 = __builtin_nontemporal_load(pk + id1); \
        st.a0 = __builtin_nontemporal_load((const u32x4*)(HA + (size_t)(cc) * 4096) + id0); st.d = HD[(size_t)(cc) * 128 + (F.tid & 127)]; \
        st.v0 = __builtin_nontemporal_load((const u32x4*)(HV + (size_t)(cc) * 8192 + vidx)); st.v1 = __builtin_nontemporal_load((const u32x4*)(HV + (size_t)(cc) * 8192 + vidx + 32)); } while (0)
#define S2_WRITE(st, bufo) do { *(LAS u32x4*)(L + (bufo) + B_QT + qoff0) = st.q0; *(LAS u32x4*)(L + (bufo) + B_QT + qoff1) = st.q1; *(LAS u32x4*)(L + (bufo) + B_KT + koff0) = st.k0; *(LAS u32x4*)(L + (bufo) + B_KT + koff1) = st.k1; \
        *(LAS u32x4*)(L + (bufo) + B_A + koff0) = st.a0; if (F.tid < 128) *(LAS float*)(L + (bufo) + B_DEC + F.tid * 4) = st.d; } while (0)
#define S2_ITER(cc, sx, sz) do { if ((cc) < 68) { LAS unsigned char* Lb = L + ((cc) & 1) * B_STRIDE; const int bn = (((cc) + 1) & 1) * B_STRIDE; \
        if ((cc) + 3 < 68) S2_LOAD(sz, (cc) + 3); \
        bf16x8 sb[4]; \
        _Pragma("unroll") for (int u = 0; u < 4; ++u) { u32x4 t; t.x = cvtpk(Sacc[2 * u][0], Sacc[2 * u][1]); t.y = cvtpk(Sacc[2 * u][2], Sacc[2 * u][3]); t.z = cvtpk(Sacc[2 * u + 1][0], Sacc[2 * u + 1][1]); t.w = cvtpk(Sacc[2 * u + 1][2], Sacc[2 * u + 1][3]); sb[u] = __builtin_bit_cast(bf16x8, t); } \
        const bf16x8 vf0 = __builtin_bit_cast(bf16x8, vc0), vf1 = __builtin_bit_cast(bf16x8, vc1); \
        f32x4 o[4]; \
        _Pragma("unroll") for (int tt = 0; tt < 4; ++tt) { const bf16x8 af = *(const LAS bf16x8*)(Lb + B_A + (16 * tt + fr) * 144 + (8 * fq) * 2); o[tt] = mfma16(af, vf0, (f32x4){0.f, 0.f, 0.f, 0.f}); } \
        _Pragma("unroll") for (int tt = 2; tt < 4; ++tt) { const bf16x8 af = *(const LAS bf16x8*)(Lb + B_A + (16 * tt + fr) * 144 + (32 + 8 * fq) * 2); o[tt] = mfma16(af, vf1, o[tt]); } \
        _Pragma("unroll") for (int u = 0; u < 4; ++u) \
            _Pragma("unroll") for (int tt = 0; tt < 4; ++tt) { const LAS unsigned char* qp = Lb + B_QT + (16 * tt + fr) * 272 + (32 * u + 4 * fq) * 2; \
                const s16x4 lo = *(const LAS s16x4*)qp, hi = *(const LAS s16x4*)(qp + 32); \
                o[tt] = mfma16((bf16x8){lo[0], lo[1], lo[2], lo[3], hi[0], hi[1], hi[2], hi[3]}, sb[u], o[tt]); } \
        _Pragma("unroll") for (int T = 0; T < 8; ++T) { const f32x4 dv = *(const LAS f32x4*)(Lb + B_DEC + (16 * T + 4 * fq) * 4); Sacc[T] = Sacc[T] * dv; } \
        _Pragma("unroll") for (int T = 0; T < 8; ++T) { const bf16x8 kf = *(const LAS bf16x8*)(Lb + B_KT + (16 * T + fr) * 144 + (8 * fq) * 2); Sacc[T] = mfma16(kf, vf0, Sacc[T]); } \
        _Pragma("unroll") for (int T = 0; T < 8; ++T) { const bf16x8 kf = *(const LAS bf16x8*)(Lb + B_KT + (16 * T + fr) * 144 + (32 + 8 * fq) * 2); Sacc[T] = mfma16(kf, vf1, Sacc[T]); } \
          \
        _Pragma("unroll") for (int tt = 0; tt < 4; ++tt) _Pragma("unroll") for (int i = 0; i < 4; ++i) *(LAS float*)(osw + ((16 * tt + 4 * fq + i) * 20 + fr) * 4) = o[tt][i]; \
        asm volatile("s_waitcnt lgkmcnt(0)" ::: "memory"); \
        _Pragma("unroll") for (int j = 0; j < 2; ++j) { const int row = (F.lane >> 1) + 32 * j, hf = F.lane & 1; const int tp = scan_pos((cc) * 64 + row, d); \
            const f32x4 oa = *(const LAS f32x4*)(osw + (row * 20 + 8 * hf) * 4), ob = *(const LAS f32x4*)(osw + (row * 20 + 8 * hf + 4) * 4); \
            u32x4 ow; ow.x = cvtpk(oa[0], oa[1]); ow.y = cvtpk(oa[2], oa[3]); ow.z = cvtpk(ob[0], ob[1]); ow.w = cvtpk(ob[2], ob[3]); \
            *(u32x4*)(OD + (size_t)(b * TPS + tp) * 512 + h * 128 + 16 * w + 8 * hf) = ow; } \
        if ((cc) + 1 < 68) { S2_WRITE(sx, bn); vc0 = sx.v0; vc1 = sx.v1; } \
        __syncthreads(); } } while (0)
    LAS unsigned char* osw = L + OS_OFF + w * 5120;
    S2Stage sA, sB, sC; u32x4 vc0, vc1;
    __syncthreads();
    S2_LOAD(sA, 0); S2_WRITE(sA, 0); vc0 = sA.v0; vc1 = sA.v1;
    S2_LOAD(sA, 1); S2_LOAD(sB, 2);
    __syncthreads();
    for (int c = 0; c < 68; c += 3) {
        S2_ITER(c, sA, sC);
        S2_ITER(c + 1, sB, sA);
        S2_ITER(c + 2, sC, sB);
    }
#undef S2_LOAD
#undef S2_WRITE
#undef S2_ITER
}
__device__ __forceinline__ void sgu_unit(Frame& F, int b, int cch, int g, bool stage_w) {
    const bf16_t* Z = (const bf16_t*)(F.ws + WS_R1); bf16_t* Y = (bf16_t*)(F.ws + WS_Y);
    const int rowbase = b * TPS + cch * 128;
    LAS unsigned char* WS = F.lds;
    LAS unsigned char* VT = F.lds + 128 * 272;
    __syncthreads();
    if (stage_w) { const float* wsrc = F.in[IN_SGUW] + (size_t)g * 128 * 128;
#pragma unroll
        for (int j = 0; j < 8; ++j) { const int e = (F.tid + NTHR * j) * 4; const int t = e >> 7, s = e & 127; const f32x4 w = *(const f32x4*)(wsrc + e);
            u32x2 o; o.x = pk2(w[0], w[1]); o.y = pk2(w[2], w[3]); *(LAS u32x2*)(WS + t * 272 + s * 2) = o; } }
    unsigned zzv[16];
#pragma unroll
    for (int i = 0; i < 16; ++i) zzv[i] = *(const unsigned*)(Z + (size_t)(rowbase + F.wave * 16 + i) * ABIN + 512 + g * 128 + 2 * F.lane);
#pragma unroll
    for (int i = 0; i < 16; ++i) { const int s = F.wave * 16 + i;
        const unsigned zz = zzv[i];
        const float a = gelu_f(bflo(zz)), c = gelu_f(bfhi(zz));
        const float mu = wave_sum(a + c) * (1.0f / 128.0f); const float da = a - mu, dc = c - mu;
        const float var = wave_sum(da * da + dc * dc) * (1.0f / 128.0f); const float rs = 1.0f / sqrtf(var + EPS);
        *(LAS unsigned short*)(VT + (2 * F.lane) * 272 + s * 2) = (unsigned short)f2bf(da * rs);
        *(LAS unsigned short*)(VT + (2 * F.lane + 1) * 272 + s * 2) = (unsigned short)f2bf(dc * rs); }
    __syncthreads();
    const int fr = F.lane & 15, fq = F.lane >> 4, t = F.wave * 16 + fr;
    bf16x8 wf[4];
#pragma unroll
    for (int ks = 0; ks < 4; ++ks) wf[ks] = *(const LAS bf16x8*)(WS + t * 272 + (ks * 32 + fq * 8) * 2);
    const float bsv = F.in[IN_SGUB][g * 128 + t];
    const bf16_t* zu = Z + (size_t)(rowbase + t) * ABIN + g * 128; bf16_t* yo = Y + (size_t)(rowbase + t) * DM + g * 128;
#pragma unroll
    for (int ct = 0; ct < 8; ++ct) {
        f32x4 acc = (f32x4){0.f, 0.f, 0.f, 0.f};
#pragma unroll
        for (int ks = 0; ks < 4; ++ks) { const bf16x8 vf = *(const LAS bf16x8*)(VT + (ct * 16 + fr) * 272 + (ks * 32 + fq * 8) * 2);
            acc = __builtin_amdgcn_mfma_f32_16x16x32_bf16(vf, wf[ks], acc, 0, 0, 0); }
        const int c0 = ct * 16 + 4 * fq;
        const u32x2 uu = *(const u32x2*)(zu + c0);
        const float u0 = gelu_f(bflo(uu.x)), u1 = gelu_f(bfhi(uu.x)), u2 = gelu_f(bflo(uu.y)), u3 = gelu_f(bfhi(uu.y));
        u32x2 o; o.x = pk2(u0 * (acc[0] + bsv), u1 * (acc[1] + bsv)); o.y = pk2(u2 * (acc[2] + bsv), u3 * (acc[3] + bsv));
        *(u32x2*)(yo + c0) = o;
    }
}
__device__ __forceinline__ void ph_hgrn_post(Frame& F) {
    const bf16_t* Z = (const bf16_t*)(F.ws + WS_R1); bf16_t* Y = (bf16_t*)(F.ws + WS_Y);
    const bf16_t* OD0 = (const bf16_t*)(F.ws + WS_R2); const bf16_t* OD1 = OD0 + (size_t)MROWS * 512;
    const int gw = F.bid * NWAVES + F.wave, NGW = F.G * NWAVES;
    const f32x4 ng0 = *(const f32x4*)(F.in[IN_HNG] + 8 * F.lane), ng1 = *(const f32x4*)(F.in[IN_HNG] + 8 * F.lane + 4);
    u32x4 an = (u32x4){0u, 0u, 0u, 0u}, cn = an, zn = an;
    if (gw < MROWS) { an = *(const u32x4*)(OD0 + (size_t)gw * 512 + 8 * F.lane); cn = *(const u32x4*)(OD1 + (size_t)gw * 512 + 8 * F.lane); zn = *(const u32x4*)(Z + (size_t)gw * ABIN + 3072 + 8 * F.lane); }
    for (int row = gw; row < MROWS; row += NGW) {
        const u32x4 a = an, c = cn, zg = zn;
        if (row + NGW < MROWS) { const size_t r2 = (size_t)(row + NGW); an = *(const u32x4*)(OD0 + r2 * 512 + 8 * F.lane); cn = *(const u32x4*)(OD1 + r2 * 512 + 8 * F.lane); zn = *(const u32x4*)(Z + r2 * ABIN + 3072 + 8 * F.lane); }
        float o[8]; float ss = 0.f;
#pragma unroll
        for (int j = 0; j < 4; ++j) { o[2 * j] = bflo(a[j]) + bflo(c[j]); o[2 * j + 1] = bfhi(a[j]) + bfhi(c[j]); ss += o[2 * j] * o[2 * j] + o[2 * j + 1] * o[2 * j + 1]; }
#pragma unroll
        for (int m = 1; m < 16; m <<= 1) ss += __shfl_xor(ss, m);
        const float rs = 1.0f / sqrtf(ss * (1.0f / 128.0f) + EPS);
        u32x4 w;
        w.x = cvtpk(o[0] * rs * ng0[0] * silu_f(bflo(zg.x)), o[1] * rs * ng0[1] * silu_f(bfhi(zg.x)));
        w.y = cvtpk(o[2] * rs * ng0[2] * silu_f(bflo(zg.y)), o[3] * rs * ng0[3] * silu_f(bfhi(zg.y)));
        w.z = cvtpk(o[4] * rs * ng1[0] * silu_f(bflo(zg.z)), o[5] * rs * ng1[1] * silu_f(bfhi(zg.z)));
        w.w = cvtpk(o[6] * rs * ng1[2] * silu_f(bflo(zg.w)), o[7] * rs * ng1[3] * silu_f(bfhi(zg.w)));
        *(u32x4*)(Y + (size_t)row * DM + 512 + 8 * F.lane) = w;
    }
}
__device__ __forceinline__ void ph_norm2_router(Frame& F, int l) {
    const float* MOD = (const float*)(F.ws + WS_MOD) + (size_t)l * 9 * 6144; const float* X = (const float*)(F.ws + WS_X); bf16_t* XN = (bf16_t*)(F.ws + WS_XN); float* AFF = (float*)(F.ws + WS_AFF);
    const float* RW = F.in[IN_RW] + (size_t)l * 1024 * 16;
    LAS float* rwT = (LAS float*)F.lds;
    __syncthreads();
    for (int i = F.tid; i < 4096; i += NTHR) { const int col = i >> 2, q = i & 3; const f32x4 w = *(const f32x4*)(RW + (size_t)col * 16 + 4 * q);
        rwT[(4 * q + 0) * 1024 + col] = w[0]; rwT[(4 * q + 1) * 1024 + col] = w[1]; rwT[(4 * q + 2) * 1024 + col] = w[2]; rwT[(4 * q + 3) * 1024 + col] = w[3]; }
    __syncthreads();
    const int gw = F.bid * NWAVES + F.wave, NGW = F.G * NWAVES;
    for (int row = gw; row < MROWS; row += NGW) {
        const int t = row % TPS; if (l == 1 && t < CTXL) continue;
        const float* md = MOD + (size_t)mod_s(row) * 6144;
        f32x4 v[4], hh[4];
#pragma unroll
        for (int j = 0; j < 4; ++j) v[j] = __builtin_nontemporal_load((const f32x4*)(X + (size_t)row * DM) + F.lane + 64 * j);
        const float rstd = row_rstd(v);
        modulate_store(v, rstd, F.in[IN_N2G] + l * 1024, md + 3072, md + 4096, XN + (size_t)row * DM, F.lane, &hh);
        float lg[16];
#pragma unroll
        for (int e = 0; e < 16; ++e) { float a = 0.f;
#pragma unroll
            for (int j = 0; j < 4; ++j) { const f32x4 w = *(const LAS f32x4*)(rwT + e * 1024 + 4 * F.lane + 256 * j); a += (hh[j][0] * w[0] + hh[j][1] * w[1]) + (hh[j][2] * w[2] + hh[j][3] * w[3]); }
            lg[e] = a; if ((e & 3) == 3) asm volatile("" ::: "memory"); }
        const bool b5 = F.lane & 32, b4 = F.lane & 16, b3 = F.lane & 8, b2 = F.lane & 4;
        float a8[8], a4[4], a2[2];
#pragma unroll
        for (int i = 0; i < 8; ++i) { const float keep = b5 ? lg[i + 8] : lg[i], send = b5 ? lg[i] : lg[i + 8]; a8[i] = keep + __shfl_xor(send, 32); }
#pragma unroll
        for (int i = 0; i < 4; ++i) { const float keep = b4 ? a8[i + 4] : a8[i], send = b4 ? a8[i] : a8[i + 4]; a4[i] = keep + __shfl_xor(send, 16); }
#pragma unroll
        for (int i = 0; i < 2; ++i) { const float keep = b3 ? a4[i + 2] : a4[i], send = b3 ? a4[i] : a4[i + 2]; a2[i] = keep + __shfl_xor(send, 8); }
        float lgt; { const float keep = b2 ? a2[1] : a2[0], send = b2 ? a2[0] : a2[1]; lgt = keep + __shfl_xor(send, 4); }
        lgt += __shfl_xor(lgt, 2); lgt += __shfl_xor(lgt, 1);
        float mx = lgt;
#pragma unroll
        for (int o = 4; o < 64; o <<= 1) mx = fmaxf(mx, __shfl_xor(mx, o));
        const float ex = expf(lgt - mx); float den = ex;
#pragma unroll
        for (int o = 4; o < 64; o <<= 1) den += __shfl_xor(den, o);
        if ((F.lane & 3) == 0) AFF[(size_t)row * 16 + (F.lane >> 2)] = ex / den;
    }
}
__device__ __forceinline__ void topk_task(Frame& F, int e, int rowbase, int n, int cap, int slot0, int rpe) {
    const float* AFF = (const float*)(F.ws + WS_AFF); int* SLOT = (int*)(F.ws + WS_SLOT); int* RL = (int*)(F.ws + WS_RLIST);
    LAS unsigned* sh = (LAS unsigned*)F.lds;
    unsigned key[8];
#pragma unroll
    for (int i = 0; i < 8; ++i) { const int idx = F.tid * 8 + i; key[i] = (idx < n) ? __float_as_uint(AFF[(size_t)(rowbase + idx) * 16 + e]) : 0u; }
    unsigned prefix = 0u, kk = (unsigned)cap;
    __syncthreads();
#pragma unroll
    for (int pass = 0; pass < 4; ++pass) {
        const int shift = 24 - 8 * pass;
        if (F.tid < 256) sh[F.tid] = 0u;
        __syncthreads();
#pragma unroll
        for (int i = 0; i < 8; ++i) { const int idx = F.tid * 8 + i; bool ok = idx < n; if (pass > 0) ok = ok && ((key[i] >> (shift + 8)) == (prefix >> (shift + 8)));
            if (ok) (void)__hip_atomic_fetch_add(&sh[(key[i] >> shift) & 255u], 1u, __ATOMIC_RELAXED, __HIP_MEMORY_SCOPE_WORKGROUP); }
        __syncthreads();
        if (F.wave == 0) {
            const unsigned h0 = sh[4 * F.lane], h1 = sh[4 * F.lane + 1], h2 = sh[4 * F.lane + 2], h3 = sh[4 * F.lane + 3];
            unsigned Ssum = h0 + h1 + h2 + h3;
#pragma unroll
            for (int o = 1; o < 64; o <<= 1) { const unsigned tv = __shfl_down(Ssum, o); if (F.lane + o < 64) Ssum += tv; }
            unsigned Sn = __shfl_down(Ssum, 1); if (F.lane == 63) Sn = 0u;
            if (Ssum >= kk && Sn < kk) {
                unsigned cum = Sn; unsigned bin, knew;
                if (cum + h3 >= kk) { bin = 4 * F.lane + 3; knew = kk - cum; }
                else { cum += h3; if (cum + h2 >= kk) { bin = 4 * F.lane + 2; knew = kk - cum; }
                    else { cum += h2; if (cum + h1 >= kk) { bin = 4 * F.lane + 1; knew = kk - cum; } else { cum += h1; bin = 4 * F.lane; knew = kk - cum; } } }
                sh[256] = bin; sh[257] = knew;
            }
        }
        __syncthreads();
        prefix |= sh[256] << shift; kk = sh[257];
        __syncthreads();
    }
    const unsigned T = prefix, krem = kk;
    unsigned cg = 0u, ce = 0u;
#pragma unroll
    for (int i = 0; i < 8; ++i) { const int idx = F.tid * 8 + i; if (idx < n) { cg += (key[i] > T) ? 1u : 0u; ce += (key[i] == T) ? 1u : 0u; } }
    const unsigned packed = cg | (ce << 16); unsigned incl = packed;
#pragma unroll
    for (int o = 1; o < 64; o <<= 1) { const unsigned tv = __shfl_up(incl, o); if (F.lane >= o) incl += tv; }
    if (F.lane == 63) sh[300 + F.wave] = incl;
    __syncthreads();
    unsigned wp = 0u;
#pragma unroll
    for (int w = 0; w < 8; ++w) wp += (w < F.wave) ? sh[300 + w] : 0u;
    const unsigned excl = incl - packed + wp;
    unsigned gtb = excl & 0xffffu, eqb = excl >> 16;
#pragma unroll
    for (int i = 0; i < 8; ++i) { const int idx = F.tid * 8 + i;
        if (idx < n) { const int row = rowbase + idx; int slot = -1;
            if (key[i] > T) { slot = (int)(gtb + (eqb < krem ? eqb : krem)); ++gtb; }
            else if (key[i] == T) { if (eqb < krem) slot = (int)(gtb + eqb); ++eqb; }
            SLOT[(size_t)row * 16 + e] = (slot >= 0) ? (slot0 + slot) : -1;
            if (slot >= 0) RL[e * rpe + slot0 + slot] = row; } }
    __syncthreads();
}
__device__ __forceinline__ void ph_topk(Frame& F, int l) {
    const int ntask = (l == 0) ? 256 : 128, rpe = (l == 0) ? 4352 : 4096;
    for (int it = F.bid; it < ntask; it += F.G) {
        if (it < 128) { const int b = it >> 4, e = it & 15; topk_task(F, e, b * TPS + CTXL, SEQ, CAP_LAT, b * CAP_LAT, rpe); }
        else { const int q = it - 128, b = q >> 4, e = q & 15; topk_task(F, e, b * TPS, CTXL, CAP_CTX, NB * CAP_LAT + b * CAP_CTX, rpe); }
    }
}
__device__ __forceinline__ void ph_combine(Frame& F, int l) {
    const float* MODl = (const float*)(F.ws + WS_MOD) + (size_t)l * 9 * 6144; float* X = (float*)(F.ws + WS_X); bf16_t* XN = (bf16_t*)(F.ws + WS_XN);
    const float* AFF = (const float*)(F.ws + WS_AFF); const int* SLOT = (const int*)(F.ws + WS_SLOT); const bf16_t* YE = (const bf16_t*)(F.ws + WS_R2);
    const int rpe = (l == 0) ? 4352 : 4096;
    const int gw = F.bid * NWAVES + F.wave, NGW = F.G * NWAVES;
    for (int row = gw; row < MROWS; row += NGW) {
        const int b = row / TPS, t = row - b * TPS; if (l == 1 && t < CTXL) continue;
        const float* md = MODl + (size_t)((t < CTXL) ? 8 : b) * 6144;
        f32x4 v[4], a[4];
#pragma unroll
        for (int j = 0; j < 4; ++j) { v[j] = __builtin_nontemporal_load((const f32x4*)(X + (size_t)row * DM) + F.lane + 64 * j); a[j] = (f32x4){0.f, 0.f, 0.f, 0.f}; }
        { int sv = -1; float av = 0.f;
          if (F.lane < 16) { sv = SLOT[(size_t)row * 16 + F.lane]; av = AFF[(size_t)row * 16 + F.lane]; }
          unsigned long long m = __ballot(sv >= 0);
          while (m) {
              const int e0 = __builtin_ctzll(m); m &= m - 1; const int s0 = __builtin_amdgcn_readlane(sv, e0); const float g0 = __uint_as_float(__builtin_amdgcn_readlane(__float_as_uint(av), e0));
              const bool two = (m != 0ull); int e1 = e0, s1 = s0; float g1 = 0.f;
              if (two) { e1 = __builtin_ctzll(m); m &= m - 1; s1 = __builtin_amdgcn_readlane(sv, e1); g1 = __uint_as_float(__builtin_amdgcn_readlane(__float_as_uint(av), e1)); }
              const bf16_t* y0 = YE + ((size_t)e0 * rpe + s0) * DM; const bf16_t* y1 = YE + ((size_t)e1 * rpe + s1) * DM;
              u32x2 w0[4], w1[4];
#pragma unroll
              for (int j = 0; j < 4; ++j) { w0[j] = __builtin_nontemporal_load((const u32x2*)(y0 + 4 * F.lane + 256 * j)); w1[j] = __builtin_nontemporal_load((const u32x2*)(y1 + 4 * F.lane + 256 * j)); }
#pragma unroll
              for (int j = 0; j < 4; ++j) { a[j][0] += g0 * bflo(w0[j].x) + g1 * bflo(w1[j].x); a[j][1] += g0 * bfhi(w0[j].x) + g1 * bfhi(w1[j].x); a[j][2] += g0 * bflo(w0[j].y) + g1 * bflo(w1[j].y); a[j][3] += g0 * bfhi(w0[j].y) + g1 * bfhi(w1[j].y); } } }
        const float gm = (DBG_SKIP & (l == 0 ? 2 : 8)) ? 0.f : 1.f;
#pragma unroll
        for (int j = 0; j < 4; ++j) { const f32x4 g2 = *(const f32x4*)(md + 5 * 1024 + 4 * F.lane + 256 * j); v[j] = v[j] + g2 * a[j] * gm; }
        const float rstd = row_rstd(v);
        if (l == 0) {
#pragma unroll
            for (int j = 0; j < 4; ++j) *((f32x4*)(X + (size_t)row * DM) + F.lane + 64 * j) = v[j];
            const float* md1 = (const float*)(F.ws + WS_MOD) + (size_t)(9 + ((t < CTXL) ? 8 : b)) * 6144;
            modulate_store(v, rstd, F.in[IN_N1G] + 1024, md1, md1 + 1024, XN + (size_t)row * DM, F.lane, nullptr);
        } else {
            float* orow = F.out + (size_t)(b * SEQ + (t - CTXL)) * DM;
#pragma unroll
            for (int j = 0; j < 4; ++j) { const f32x4 fg = *(const f32x4*)(F.in[IN_FG] + 4 * F.lane + 256 * j); *((f32x4*)orow + F.lane + 64 * j) = v[j] * rstd * fg; }
        }
    }
}
__device__ __forceinline__ void attn_unit(Frame& F, int b, int kvh, int qb) {
    const bf16_t* QKV = (const bf16_t*)(F.ws + WS_R1); bf16_t* O = (bf16_t*)(F.ws + WS_Y);
    LAS unsigned char* KL = F.lds;
    LAS unsigned char* VT = F.lds + 9216;
    const int r = F.lane & 31, h = F.lane >> 5, g = F.wave >> 1, qh = F.wave & 1, hq = kvh * 4 + g;
    const size_t rowlat0 = (size_t)b * TPS + CTXL;
    const int q0 = qb * 128 + qh * 64;
    bf16x8 qf[2][4];
#pragma unroll
    for (int sub = 0; sub < 2; ++sub)
#pragma unroll
        for (int ks = 0; ks < 4; ++ks) qf[sub][ks] = *(const bf16x8*)(QKV + (rowlat0 + q0 + sub * 32 + r) * QKVD + hq * 64 + ks * 16 + h * 8);
    float mrun[2], lrun[2]; f32x16 o[2][2];
#pragma unroll
    for (int sub = 0; sub < 2; ++sub) { mrun[sub] = F.in[IN_SINK][hq] * 1.4426950408889634f; lrun[sub] = (h == 0) ? 1.f : 0.f;
#pragma unroll
        for (int db = 0; db < 2; ++db)
#pragma unroll
            for (int i = 0; i < 16; ++i) o[sub][db][i] = 0.f; }
    const int kvp = F.tid >> 3, pcs = F.tid & 7;
    constexpr int ABUF = 9216 + 8704;
    u32x4 kreg, vreg;
#define ATT_NEXT(cc) do { ++(cc); while ((cc) < 6 && ((qb * 128 - 128 + (cc) * 64) < 0 || (qb * 128 - 128 + (cc) * 64) >= SEQ)) ++(cc); } while (0)
#define ATT_LOAD(cc) do { const int kr_ = ((cc) < 6) ? (b * TPS + CTXL + qb * 128 - 128 + (cc) * 64) : (b * TPS + ((cc) - 6) * 64); \
        const bf16_t* kp_ = QKV + (size_t)(kr_ + kvp) * QKVD + 1024 + kvh * 64 + pcs * 8; kreg = *(const u32x4*)kp_; vreg = *(const u32x4*)(kp_ + 256); } while (0)
#define ATT_WRITE(bo) do { *(LAS u32x4*)(KL + (bo) + kvp * 144 + pcs * 16) = kreg; \
        _Pragma("unroll") for (int i = 0; i < 8; ++i) { const unsigned w_ = vreg[i >> 1]; *(LAS unsigned short*)(VT + (bo) + (pcs * 8 + i) * 136 + kvp * 2) = (unsigned short)((i & 1) ? (w_ >> 16) : (w_ & 0xffffu)); } } while (0)
    int c = -1; ATT_NEXT(c);
    int c1 = c; ATT_NEXT(c1);
    __syncthreads();
    ATT_LOAD(c); ATT_WRITE(0);
    if (c1 < 10) ATT_LOAD(c1);
    __syncthreads();
    for (int it = 0; c < 10; ++it) {
        const int bo = (it & 1) * ABUF, bn = ((it + 1) & 1) * ABUF;
        const bool local = c < 6; const int j0 = qb * 128 - 128 + c * 64;
        int c2 = c1; if (c1 < 10) ATT_NEXT(c2);
#pragma unroll
        for (int sub = 0; sub < 2; ++sub) {
            const int orel = qh * 64 + sub * 32, cs = 64 * c;
            if (local && !(cs <= orel + 287 && cs + 63 >= orel)) continue;
            const bool needmask = local && !((cs - orel <= 193) && (cs - orel >= 31));
            f32x16 s[2];
#pragma unroll
            for (int kb = 0; kb < 2; ++kb) {
#pragma unroll
                for (int i = 0; i < 16; ++i) s[kb][i] = 0.f;
#pragma unroll
                for (int ks = 0; ks < 4; ++ks) { const bf16x8 kf = *(const LAS bf16x8*)(KL + bo + (kb * 32 + r) * 144 + (ks * 16 + h * 8) * 2);
                    s[kb] = __builtin_amdgcn_mfma_f32_32x32x16_bf16(kf, qf[sub][ks], s[kb], 0, 0, 0); } }
            if (needmask) { const int qi = q0 + sub * 32 + r;
#pragma unroll
                for (int kb = 0; kb < 2; ++kb)
#pragma unroll
                    for (int i = 0; i < 16; ++i) { const int dd = j0 + kb * 32 + (i & 3) + 8 * (i >> 2) + 4 * h - qi; if (dd > 128 || dd < -128) s[kb][i] = -INFINITY; } }
            float mx = fmaxf(s[0][0], s[1][0]);
#pragma unroll
            for (int i = 1; i < 16; ++i) mx = fmaxf(mx, fmaxf(s[0][i], s[1][i]));
            mx = fmaxf(mx, __shfl_xor(mx, 32));
            const float mn = fmaxf(mrun[sub], mx);
            if (__any(mn > mrun[sub])) { const float alpha = __builtin_amdgcn_exp2f(mrun[sub] - mn); lrun[sub] *= alpha;
#pragma unroll
                for (int db = 0; db < 2; ++db)
#pragma unroll
                    for (int i = 0; i < 16; ++i) o[sub][db][i] *= alpha; }
            mrun[sub] = mn;
            float ps = 0.f;
#pragma unroll
            for (int kb = 0; kb < 2; ++kb)
#pragma unroll
                for (int i = 0; i < 16; ++i) { const float p = __builtin_amdgcn_exp2f(s[kb][i] - mn); s[kb][i] = p; ps += p; }
            lrun[sub] += ps;
#pragma unroll
            for (int kb = 0; kb < 2; ++kb)
#pragma unroll
                for (int st = 0; st < 2; ++st) {
                    u32x4 pw; pw.x = cvtpk(s[kb][8 * st], s[kb][8 * st + 1]); pw.y = cvtpk(s[kb][8 * st + 2], s[kb][8 * st + 3]); pw.z = cvtpk(s[kb][8 * st + 4], s[kb][8 * st + 5]); pw.w = cvtpk(s[kb][8 * st + 6], s[kb][8 * st + 7]);
                    const bf16x8 pf = __builtin_bit_cast(bf16x8, pw);
#pragma unroll
                    for (int db = 0; db < 2; ++db) { const LAS unsigned char* vp = VT + bo + (db * 32 + r) * 136 + (kb * 32 + 16 * st + 4 * h) * 2;
                        const s16x4 lo = *(const LAS s16x4*)vp, hi = *(const LAS s16x4*)(vp + 16);
                        const bf16x8 vf = (bf16x8){lo[0], lo[1], lo[2], lo[3], hi[0], hi[1], hi[2], hi[3]};
                        o[sub][db] = __builtin_amdgcn_mfma_f32_32x32x16_bf16(vf, pf, o[sub][db], 0, 0, 0); } }
        }
        if (c1 < 10) { ATT_WRITE(bn); if (c2 < 10) ATT_LOAD(c2); }
        __syncthreads();
        c = c1; c1 = c2;
    }
#pragma unroll
    for (int sub = 0; sub < 2; ++sub) { const float lt = lrun[sub] + __shfl_xor(lrun[sub], 32); const float inv = 1.0f / lt;
        bf16_t* orow = O + (rowlat0 + q0 + sub * 32 + r) * DM + hq * 64;
#pragma unroll
        for (int db = 0; db < 2; ++db)
#pragma unroll
            for (int i4 = 0; i4 < 4; ++i4) { u32x2 w; w.x = cvtpk(o[sub][db][4 * i4] * inv, o[sub][db][4 * i4 + 1] * inv); w.y = cvtpk(o[sub][db][4 * i4 + 2] * inv, o[sub][db][4 * i4 + 3] * inv);
                *(u32x2*)(orow + db * 32 + 8 * i4 + 4 * h) = w; } }
    __syncthreads();
#undef ATT_LOAD
#undef ATT_WRITE
#undef ATT_NEXT
}

__global__ void __launch_bounds__(NTHR, 2) hybrid_fwd(Args args) {
    extern __shared__ __attribute__((aligned(16))) unsigned char lds_raw[];
    Frame F;
    F.lds = (LAS unsigned char*)lds_raw;
    F.tid = threadIdx.x; F.lane = F.tid & 63; F.wave = __builtin_amdgcn_readfirstlane(F.tid >> 6);
    F.G = gridDim.x; F.bid = blockIdx.x;
#pragma unroll
    for (int i = 0; i < 22; ++i) F.in[i] = args.in[i];
    F.out = args.out; F.ws = args.ws;
    volatile LAS unsigned* MISC = (volatile LAS unsigned*)(F.lds + MISC_OFF);
    for (int u = F.tid; u < (LDS_BYTES - LDSCTL_OFF) / 4; u += NTHR) ((LAS unsigned*)(F.lds + LDSCTL_OFF))[u] = 0u;
    __syncthreads();
    unsigned* ctl = (unsigned*)(F.ws + WS_CTL);
    XcdBarrier bar = xcd_barrier_post(ctl + CW_BAR, MISC + 8);
    const int lo = args.ph_lo, hi = args.ph_hi;
#define IN(k) (lo <= (k) && (k) < hi)
#define REPS(k) for (int rep_ = 0; rep_ < (((REP_MASK >> (k)) & 1) ? 2 : 1); ++rep_, (void)((rep_ == 1 && ((REP_MASK >> (k)) & 1)) ? (xcd_barrier(bar), 0) : 0))
#define SEAM(k) do { if (IN(k) && IN((k) + 1)) xcd_barrier(bar); if (TS_HI == (k) && F.bid == 0 && F.tid == 0) ts1 = __builtin_amdgcn_s_memrealtime(); if (TS_LO == (k) + 1 && F.bid == 0 && F.tid == 0) ts0 = __builtin_amdgcn_s_memrealtime(); } while (0)
    const float* MOD = (const float*)(F.ws + WS_MOD);
    unsigned long long ts0 = 0, ts1 = 0;
    if (TS_LO == 0 && F.bid == 0 && F.tid == 0) ts0 = __builtin_amdgcn_s_memrealtime();

    if (IN(0)) REPS(0) { ph_prologue(F); } SEAM(0);
    if (IN(1)) REPS(1) { ph_xn0(F); } SEAM(1);
    if (IN(2)) REPS(2) {
        pg8::Gemm g{(const bf16_t*)(F.ws + WS_XN), (const bf16_t*)(F.ws + WS_WIN), 1024, nullptr}; pg8::Order S{136, 14, 1, F.G, F.bid, 0, 0, 0, WGMX(1)};
        pg8::EpiStore E{(bf16_t*)(F.ws + WS_R1), ABIN};
        pg8::gemm_phase<pg8::EpiStore, true, false>(F.lds, g, S, E);
        if (F.bid >= 112) conv_range(F, 0, CV_G1, F.G - 112, F.bid - 112);
    } SEAM(2);
    if (IN(3)) REPS(3) {
        for (int u = F.bid; u < 64 * 68; u += F.G) scan_s1_unit(F, u);
        __syncthreads();
        for (int u = F.bid; u < NB * 34 * 4; u += F.G) { const int g = u & 3, q = u >> 2; sgu_unit(F, q / 34, q % 34, g, (u == F.bid) || (F.G & 3)); }
        xcd_barrier(bar);
        if (F.bid < 64) { scan_s2_unit(F, F.bid >> 3, (F.bid >> 1) & 3, F.bid & 1); }
        else { const int c = F.bid - 64, nb = F.G - 64;
            conv_range(F, CV_G1 + CV_G2, 49152, nb, c); conv_range(F, 49152 + CV_G4 + CV_G5, 2 * 49152, nb, c);
        }
    } SEAM(3);
    if (IN(4)) REPS(4) { ph_hgrn_post(F); } SEAM(4);
    if (IN(5)) REPS(5) {
        pg8::Gemm g{(const bf16_t*)(F.ws + WS_Y), (const bf16_t*)(F.ws + WS_WOUT), 1024, nullptr}; pg8::Order S{136, 4, 1, F.G, F.bid, 0, 0, 0, WGMX(1)};
        pg8::EpiResid E{F.in[IN_X], F.in[IN_CTX], (float*)(F.ws + WS_X), MOD, 1, (DBG_SKIP & 1) ? 0.f : 1.f};
        pg8::gemm_phase<pg8::EpiResid, true, false>(F.lds, g, S, E);
        if (F.bid >= 32) conv_range(F, CV_G1, CV_G1 + CV_G2, F.G - 32, F.bid - 32);
    } SEAM(5);
    if (IN(6)) REPS(6) { ph_norm2_router(F, 0); } SEAM(6);
    if (IN(7)) REPS(7) { ph_topk(F, 0); } SEAM(7);
    if (IN(8)) REPS(8) {
        pg8::Gemm g{(const bf16_t*)(F.ws + WS_XN), (const bf16_t*)(F.ws + WS_W13), 1024, (const int*)(F.ws + WS_RLIST)}; pg8::Order S{17, 16, 16, F.G, F.bid, 0, 17, 16, WGMX(16)};
        pg8::EpiSwiglu E{(bf16_t*)(F.ws + WS_R1)};
        pg8::gemm_phase<pg8::EpiSwiglu, true, true>(F.lds, g, S, E);
    } SEAM(8);
    if (IN(9)) REPS(9) {
        pg8::Gemm g{(const bf16_t*)(F.ws + WS_R1), (const bf16_t*)(F.ws + WS_W2), 2048, nullptr}; pg8::Order S{17, 4, 16, F.G, F.bid, 0, 17, 4, WGMX(16)};
        pg8::EpiStore E{(bf16_t*)(F.ws + WS_R2), DM};
        pg8::gemm_phase<pg8::EpiStore, true, false>(F.lds, g, S, E);
        if (F.bid >= 64) conv_range(F, 49152, 49152 + CV_G4, F.G - 64, F.bid - 64);
    } SEAM(9);
    if (IN(10)) REPS(10) {
        ph_combine(F, 0);
    } SEAM(10);
    if (IN(11)) REPS(11) {
        pg8::Gemm g{(const bf16_t*)(F.ws + WS_XN), (const bf16_t*)(F.ws + WS_WQKV), 1024, nullptr}; pg8::Order S{136, 6, 1, F.G, F.bid, 0, 0, 0, WGMX(1)};
        pg8::EpiQkv E{(bf16_t*)(F.ws + WS_R1), (const float*)(F.ws + WS_ROPE), (const float*)(F.ws + WS_ROPE) + 1024};
        pg8::gemm_phase<pg8::EpiQkv, true, false>(F.lds, g, S, E);
        if (F.bid >= 48) conv_range(F, 49152 + CV_G4, 49152 + CV_G4 + CV_G5, F.G - 48, F.bid - 48);
    } SEAM(11);
    if (IN(12)) REPS(12) { for (int u = F.bid; u < NB * 4 * 32; u += F.G) attn_unit(F, u >> 7, (u >> 5) & 3, u & 31); } SEAM(12);
    if (IN(13)) REPS(13) {
        pg8::Gemm g{(const bf16_t*)(F.ws + WS_Y), (const bf16_t*)(F.ws + WS_WAO), 1024, nullptr}; pg8::Order S{128, 4, 1, F.G, F.bid, 1, 0, 0, WGMX(1)};
        pg8::EpiResid E{nullptr, nullptr, (float*)(F.ws + WS_X), MOD + 9 * 6144, 0, (DBG_SKIP & 4) ? 0.f : 1.f};
        pg8::gemm_phase<pg8::EpiResid, true, false>(F.lds, g, S, E);
    } SEAM(13);
    if (IN(14)) REPS(14) { ph_norm2_router(F, 1); } SEAM(14);
    if (IN(15)) REPS(15) { ph_topk(F, 1); } SEAM(15);
    if (IN(16)) REPS(16) {
        pg8::Gemm g{(const bf16_t*)(F.ws + WS_XN), (const bf16_t*)F.out, 1024, (const int*)(F.ws + WS_RLIST)}; pg8::Order S{16, 16, 16, F.G, F.bid, 0, 16, 16, WGMX(16)};
        pg8::EpiSwiglu E{(bf16_t*)(F.ws + WS_R1)};
        pg8::gemm_phase<pg8::EpiSwiglu, true, true>(F.lds, g, S, E);
    } SEAM(16);
    if (IN(17)) REPS(17) {
        pg8::Gemm g{(const bf16_t*)(F.ws + WS_R1), (const bf16_t*)(F.ws + WS_W2B), 2048, nullptr}; pg8::Order S{16, 4, 16, F.G, F.bid, 0, 16, 4, WGMX(16)};
        pg8::EpiStore E{(bf16_t*)(F.ws + WS_R2), DM};
        pg8::gemm_phase<pg8::EpiStore, true, false>(F.lds, g, S, E);
    } SEAM(17);
    if (IN(18)) REPS(18) { ph_combine(F, 1); }
    if (TS_LO >= 0) { if (TS_HI == 18 && F.bid == 0 && F.tid == 0) ts1 = __builtin_amdgcn_s_memrealtime(); xcd_barrier(bar); if (F.bid == 0 && F.tid == 0) { const float tus = (float)(ts1 - ts0) * 0.01f; F.out[0] += sqrtf(33554432.0f * 1e-7f * tus); } }
#undef IN
#undef SEAM
}

#ifndef N_SPLIT
#define N_SPLIT 0
#endif
extern "C" void kernel_launch(void* const* d_in, const int* in_sizes, int n_in, void* d_out, int out_size, void* d_ws, size_t ws_size, hipStream_t stream) {
    static int grid = 0;
    if (grid == 0) {
        if (n_in != 22 || out_size != NB * SEQ * DM || ws_size < WS_END) { fprintf(stderr, "kernel_launch: unexpected shapes (n_in %d, out %d, ws %zu)\n", n_in, out_size, ws_size); grid = -1; return; }
        int dev = 0, cus = 0, per_cu = 0;
        if (hipGetDevice(&dev) != hipSuccess || hipDeviceGetAttribute(&cus, hipDeviceAttributeMultiprocessorCount, dev) != hipSuccess) { grid = -1; return; }
        if (hipFuncSetAttribute((const void*)hybrid_fwd, hipFuncAttributeMaxDynamicSharedMemorySize, LDS_BYTES) != hipSuccess) { fprintf(stderr, "kernel_launch: hipFuncSetAttribute failed\n"); grid = -1; return; }
        if (hipOccupancyMaxActiveBlocksPerMultiprocessor(&per_cu, (const void*)hybrid_fwd, NTHR, LDS_BYTES) != hipSuccess || per_cu < 1) { fprintf(stderr, "kernel_launch: occupancy query says %d\n", per_cu); }
        (void)hipGetLastError();
        grid = cus;
        if (grid != 256) fprintf(stderr, "kernel_launch: %d CUs; this kernel is laid out for 256\n", grid);
    }
    if (grid < 0) return;
    (void)hipMemsetAsync((char*)d_ws + WS_CTL, 0, CTL_ZERO_BYTES, stream);
    Args a{};
    for (int i = 0; i < 22; ++i) a.in[i] = (const float*)d_in[i];
    a.out = (float*)d_out; a.ws = (unsigned char*)d_ws;
#if N_SPLIT
    for (int p = 0; p < 19; ++p) { a.ph_lo = p; a.ph_hi = p + 1; hipLaunchKernelGGL(hybrid_fwd, dim3(grid), dim3(NTHR), LDS_BYTES, stream, a); }
#else
    a.ph_lo = 0; a.ph_hi = 19;
    hipLaunchKernelGGL(hybrid_fwd, dim3(grid), dim3(NTHR), LDS_BYTES, stream, a);
#endif
}
```
